# Optimizing an MI355X kernel written in HIP

```python
import math
import jax, jax.numpy as jnp
from jax import lax
import numpy as np

D_MODEL = 1024
BATCH = 4
SEQ = 4096
DEPTH = 1
DEC_BATCH = 128
DEC_SEQ = 4
PAST_LEN = 2048
PAGE_SIZE = 128

MIX_WIDTH = D_MODEL
ATTN_WIDTH = MIX_WIDTH // 2
SSM_WIDTH = MIX_WIDTH - ATTN_WIDTH
HEAD_DIM = 64
N_HEADS = ATTN_WIDTH // HEAD_DIM
SSM_GROUP = 16
N_GROUPS = SSM_WIDTH // SSM_GROUP
STATE_DIM = 64
D_FF = 4 * D_MODEL
PLE_DIM = 256
Q_BLOCK = 128
IN_WIDTH = 3 * ATTN_WIDTH + N_HEADS + SSM_WIDTH
ALPHA = (2.0 * DEPTH) ** 0.25
BETA = (8.0 * DEPTH) ** -0.25
LN_EPS = 1e-5
FGATE_BIAS = 3.0
DT_MIN = 1e-3
DT_MAX = 1e-1
NEG_INF = -1e30

kernel_name = "fox_s5_parallel_heads_deepnorm_step"


def layer_norm(x, g, b):
    xf = x.astype(jnp.float32)
    mu = jnp.mean(xf, axis=-1, keepdims=True)
    var = jnp.mean(jnp.square(xf - mu), axis=-1, keepdims=True)
    return ((xf - mu) * lax.rsqrt(var + LN_EPS) * g + b).astype(x.dtype)


def project_in(h, w_in, b_f):
    z = h @ w_in
    q, k, v, fl, u = jnp.split(z, [ATTN_WIDTH, 2 * ATTN_WIDTH, 3 * ATTN_WIDTH, 3 * ATTN_WIDTH + N_HEADS], axis=-1)
    shp = h.shape[:-1] + (N_HEADS, HEAD_DIM)
    logf = jax.nn.log_sigmoid((fl + b_f).astype(jnp.float32))
    return q.reshape(shp), k.reshape(shp), v.reshape(shp), logf, u


def fox_attend(q, k, v, cq, ck, q_pos):
    s = jnp.einsum('bqhd,bkhd->bhqk', q, k).astype(jnp.float32) * (HEAD_DIM ** -0.5)
    bias = jnp.transpose(cq, (0, 2, 1))[..., :, None] - jnp.transpose(ck, (0, 2, 1))[..., None, :]
    k_pos = jnp.arange(k.shape[1], dtype=jnp.int32)
    mask = k_pos[None, :] <= q_pos[:, None]
    s = jnp.where(mask, s + bias, NEG_INF)
    p = jax.nn.softmax(s, axis=-1).astype(v.dtype)
    return jnp.einsum('bhqk,bkhd->bqhd', p, v)


def fox_prompt(q, k, v, logf):
    b, t = q.shape[:2]
    c = jnp.cumsum(logf, axis=1)
    nb = t // Q_BLOCK
    qb = q.reshape(b, nb, Q_BLOCK, N_HEADS, HEAD_DIM).swapaxes(0, 1)
    cb = c.reshape(b, nb, Q_BLOCK, N_HEADS).swapaxes(0, 1)
    starts = jnp.arange(nb, dtype=jnp.int32) * Q_BLOCK

    def block(args):
        q_blk, c_blk, start = args
        return fox_attend(q_blk, k, v, c_blk, c, start + jnp.arange(Q_BLOCK, dtype=jnp.int32))

    o = lax.map(block, (qb, cb, starts))
    return o.swapaxes(0, 1).reshape(b, t, ATTN_WIDTH)


def fox_sample(q, k, v, logf, cache_k, cache_v, cache_logf, page_table):
    db, t = q.shape[:2]
    past_len = page_table.shape[1] * cache_k.shape[1]
    pk = cache_k[page_table].reshape(db, past_len, N_HEADS, HEAD_DIM)
    pv = cache_v[page_table].reshape(db, past_len, N_HEADS, HEAD_DIM)
    pf = cache_logf[page_table].reshape(db, past_len, N_HEADS).astype(jnp.float32)
    k_all = jnp.concatenate([pk, k.astype(pk.dtype)], axis=1)
    v_all = jnp.concatenate([pv, v.astype(pv.dtype)], axis=1)
    c = jnp.cumsum(jnp.concatenate([pf, logf], axis=1), axis=1)
    q_pos = past_len + jnp.arange(t, dtype=jnp.int32)
    o = fox_attend(q, k_all, v_all, c[:, past_len:], c, q_pos)
    return o.reshape(db, t, ATTN_WIDTH).astype(q.dtype)


def s5_discretize(lam_re, lam_im, log_dt, b_re, b_im):
    dt = jnp.exp(log_dt.astype(jnp.float32))[:, None]
    lr = lam_re.astype(jnp.float32)
    li = lam_im.astype(jnp.float32)
    mag = jnp.exp(lr * dt)
    a_re = mag * jnp.cos(li * dt)
    a_im = mag * jnp.sin(li * dt)
    nr = a_re - 1.0
    ni = a_im
    den = lr * lr + li * li
    coef_re = (nr * lr + ni * li) / den
    coef_im = (ni * lr - nr * li) / den
    br = b_re.astype(jnp.float32)
    bi = b_im.astype(jnp.float32)
    bb_re = coef_re[..., None] * br - coef_im[..., None] * bi
    bb_im = coef_re[..., None] * bi + coef_im[..., None] * br
    return a_re, a_im, bb_re, bb_im


def s5_combine(e1, e2):
    a1r, a1i, b1r, b1i = e1
    a2r, a2i, b2r, b2i = e2
    return (a2r * a1r - a2i * a1i,
            a2r * a1i + a2i * a1r,
            a2r * b1r - a2i * b1i + b2r,
            a2r * b1i + a2i * b1r + b2i)


def s5_mixer(u, h0_re, h0_im, lam_re, lam_im, log_dt, b_re, b_im, c_re, c_im, d_skip, w_glu, b_glu):
    b, t = u.shape[:2]
    ug = u.reshape(b, t, N_GROUPS, SSM_GROUP).astype(jnp.float32)
    a_re, a_im, bb_re, bb_im = s5_discretize(lam_re, lam_im, log_dt, b_re, b_im)
    bu_re = jnp.einsum('gph,btgh->btgp', bb_re, ug)
    bu_im = jnp.einsum('gph,btgh->btgp', bb_im, ug)
    ar = jnp.broadcast_to(a_re, bu_re.shape)
    ai = jnp.broadcast_to(a_im, bu_re.shape)
    acr, aci, bcr, bci = lax.associative_scan(s5_combine, (ar, ai, bu_re, bu_im), axis=1)
    h0r = h0_re.astype(jnp.float32)[:, None]
    h0i = h0_im.astype(jnp.float32)[:, None]
    hr = acr * h0r - aci * h0i + bcr
    hi = acr * h0i + aci * h0r + bci
    y = (jnp.einsum('ghp,btgp->btgh', c_re.astype(jnp.float32), hr)
         - jnp.einsum('ghp,btgp->btgh', c_im.astype(jnp.float32), hi)
         + d_skip.astype(jnp.float32) * ug)
    y = jax.nn.gelu(y.reshape(b, t, SSM_WIDTH))
    y = y * jax.nn.sigmoid(y @ w_glu.astype(jnp.float32) + b_glu.astype(jnp.float32))
    return y.astype(u.dtype), hr[:, -1], hi[:, -1]


def post_mixer(h, mix, p, w_out, ln1_g, ln1_b, w_up, w_down, w_pe, w_pg, b_pg, ln2_g, ln2_b):
    h1 = layer_norm(ALPHA * h + mix @ w_out, ln1_g, ln1_b)
    ff = jnp.square(jax.nn.relu(h1 @ w_up)) @ w_down
    e = jax.nn.sigmoid(h1 @ w_pg + b_pg) * (p @ w_pe)
    return layer_norm(ALPHA * h1 + ff + e, ln2_g, ln2_b)


def setup_inputs(seed: int = 0) -> dict:
    key = jax.random.key(seed)
    ks = iter(jax.random.split(key, 40))
    f32 = jnp.float32
    n_pages = PAST_LEN // PAGE_SIZE
    n_used = DEC_BATCH * n_pages
    n_phys = n_used + n_used // 4

    def nrm(shape, scale=1.0):
        return jax.random.normal(next(ks), shape, f32) * scale

    x_prompt = nrm((BATCH, SEQ, D_MODEL))
    x_sample = nrm((DEC_BATCH, DEC_SEQ, D_MODEL))
    cache_k = nrm((DEPTH, n_phys, PAGE_SIZE, N_HEADS, HEAD_DIM))
    cache_v = nrm((DEPTH, n_phys, PAGE_SIZE, N_HEADS, HEAD_DIM))
    cache_logf = jax.nn.log_sigmoid(FGATE_BIAS + nrm((DEPTH, n_phys, PAGE_SIZE, N_HEADS)))
    state_re = nrm((DEPTH, DEC_BATCH, N_GROUPS, STATE_DIM), 0.5)
    state_im = nrm((DEPTH, DEC_BATCH, N_GROUPS, STATE_DIM), 0.5)
    page_table = jax.random.permutation(next(ks), n_phys)[:n_used].reshape(DEC_BATCH, n_pages).astype(jnp.int32)
    p_prompt = nrm((DEPTH, BATCH, SEQ, PLE_DIM))
    p_sample = nrm((DEPTH, DEC_BATCH, DEC_SEQ, PLE_DIM))

    ln_in_g = 1.0 + nrm((D_MODEL,), 0.02)
    ln_in_b = nrm((D_MODEL,), 0.02)
    w_in = nrm((DEPTH, D_MODEL, IN_WIDTH), D_MODEL ** -0.5)
    b_f = FGATE_BIAS + nrm((DEPTH, N_HEADS), 0.1)
    n_idx = jnp.arange(STATE_DIM, dtype=f32)
    lam_re = -0.5 + nrm((DEPTH, N_GROUPS, STATE_DIM), 0.01)
    lam_im = math.pi * n_idx + nrm((DEPTH, N_GROUPS, STATE_DIM), 0.01)
    log_dt = jax.random.uniform(next(ks), (DEPTH, N_GROUPS), f32, math.log(DT_MIN), math.log(DT_MAX))
    b_re = nrm((DEPTH, N_GROUPS, STATE_DIM, SSM_GROUP), (2.0 * SSM_GROUP) ** -0.5)
    b_im = nrm((DEPTH, N_GROUPS, STATE_DIM, SSM_GROUP), (2.0 * SSM_GROUP) ** -0.5)
    c_re = nrm((DEPTH, N_GROUPS, SSM_GROUP, STATE_DIM), (2.0 * STATE_DIM) ** -0.5)
    c_im = nrm((DEPTH, N_GROUPS, SSM_GROUP, STATE_DIM), (2.0 * STATE_DIM) ** -0.5)
    d_skip = nrm((DEPTH, N_GROUPS, SSM_GROUP))
    w_glu = nrm((DEPTH, SSM_WIDTH, SSM_WIDTH), SSM_WIDTH ** -0.5)
    b_glu = nrm((DEPTH, SSM_WIDTH), 0.01)
    w_out = nrm((DEPTH, MIX_WIDTH, D_MODEL), BETA * MIX_WIDTH ** -0.5)
    ln1_g = 1.0 + nrm((DEPTH, D_MODEL), 0.02)
    ln1_b = nrm((DEPTH, D_MODEL), 0.02)
    w_up = nrm((DEPTH, D_MODEL, D_FF), D_MODEL ** -0.5)
    w_down = nrm((DEPTH, D_FF, D_MODEL), BETA * D_FF ** -0.5)
    w_pe = nrm((DEPTH, PLE_DIM, D_MODEL), BETA * PLE_DIM ** -0.5)
    w_pg = nrm((DEPTH, D_MODEL, D_MODEL), D_MODEL ** -0.5)
    b_pg = nrm((DEPTH, D_MODEL), 0.01)
    ln2_g = 1.0 + nrm((DEPTH, D_MODEL), 0.02)
    ln2_b = nrm((DEPTH, D_MODEL), 0.02)
    return {"x_prompt": x_prompt, "x_sample": x_sample, "cache_k": cache_k, "cache_v": cache_v,
            "cache_logf": cache_logf, "state_re": state_re, "state_im": state_im, "page_table": page_table,
            "p_prompt": p_prompt, "p_sample": p_sample, "ln_in_g": ln_in_g, "ln_in_b": ln_in_b,
            "w_in": w_in, "b_f": b_f, "lam_re": lam_re, "lam_im": lam_im, "log_dt": log_dt,
            "b_re": b_re, "b_im": b_im, "c_re": c_re, "c_im": c_im, "d_skip": d_skip,
            "w_glu": w_glu, "b_glu": b_glu, "w_out": w_out, "ln1_g": ln1_g, "ln1_b": ln1_b,
            "w_up": w_up, "w_down": w_down, "w_pe": w_pe, "w_pg": w_pg, "b_pg": b_pg,
            "ln2_g": ln2_g, "ln2_b": ln2_b}


def reference(x_prompt, x_sample, cache_k, cache_v, cache_logf, state_re, state_im, page_table,
              p_prompt, p_sample, ln_in_g, ln_in_b, w_in, b_f, lam_re, lam_im, log_dt,
              b_re, b_im, c_re, c_im, d_skip, w_glu, b_glu, w_out, ln1_g, ln1_b,
              w_up, w_down, w_pe, w_pg, b_pg, ln2_g, ln2_b):
    hp = layer_norm(x_prompt, ln_in_g, ln_in_b)
    hs = layer_norm(x_sample, ln_in_g, ln_in_b)
    kp_l, vp_l, fp_l, srp_l, sip_l = [], [], [], [], []
    ks_l, vs_l, fs_l, srs_l, sis_l = [], [], [], [], []
    for i in range(DEPTH):
        ssm_args = (lam_re[i], lam_im[i], log_dt[i], b_re[i], b_im[i], c_re[i], c_im[i], d_skip[i], w_glu[i], b_glu[i])
        post_args = (w_out[i], ln1_g[i], ln1_b[i], w_up[i], w_down[i], w_pe[i], w_pg[i], b_pg[i], ln2_g[i], ln2_b[i])
        q, k, v, logf, u = project_in(hp, w_in[i], b_f[i])
        att = fox_prompt(q, k, v, logf)
        h0 = jnp.zeros((hp.shape[0], N_GROUPS, STATE_DIM), jnp.float32)
        ssm, sr, si = s5_mixer(u, h0, h0, *ssm_args)
        hp = post_mixer(hp, jnp.concatenate([att, ssm], axis=-1), p_prompt[i], *post_args)
        kp_l.append(k); vp_l.append(v); fp_l.append(logf); srp_l.append(sr); sip_l.append(si)
        q, k, v, logf, u = project_in(hs, w_in[i], b_f[i])
        att = fox_sample(q, k, v, logf, cache_k[i], cache_v[i], cache_logf[i], page_table)
        ssm, sr, si = s5_mixer(u, state_re[i], state_im[i], *ssm_args)
        hs = post_mixer(hs, jnp.concatenate([att, ssm], axis=-1), p_sample[i], *post_args)
        ks_l.append(k); vs_l.append(v); fs_l.append(logf); srs_l.append(sr); sis_l.append(si)
    return (hp, hs,
            jnp.stack(kp_l), jnp.stack(vp_l), jnp.stack(fp_l), jnp.stack(srp_l), jnp.stack(sip_l),
            jnp.stack(ks_l), jnp.stack(vs_l), jnp.stack(fs_l), jnp.stack(srs_l), jnp.stack(sis_l))
```

```cpp
#include <hip/hip_runtime.h>
#include <hip/hip_bf16.h>
#include <cstdio>
#include <cstdint>
#include <cmath>

constexpr int DM_ = 1024, MP = 16384  , MS = 512  , MT = MP + MS  ;
constexpr int SEQ_ = 4096, NB_ = 4, DB_ = 128, DS_ = 4, AW = 512, NH = 8, HD = 64, NG = 32, SG = 16, SP = 64, FF_ = 4096, PLE = 256, INW = 2056;
constexpr int NPG = 16  , PGSZ = 128;
constexpr float ALPHA = 1.189207115002721f, LN_EPS = 1e-5f, LOG2E = 1.4426950408889634f;
constexpr float C2Q = 0.125f * 1.4426950408889634f;
constexpr size_t OFF_YP = 0, OFF_YS = 16777216, OFF_KP = 17301504, OFF_VP = 25690112, OFF_LFP = 34078720, OFF_SRP = 34209792, OFF_SIP = 34217984,
                 OFF_KS = 34226176, OFF_VS = 34488320, OFF_LFS = 34750464, OFF_SRS = 34754560, OFF_SIS = 35016704, OUT_TOTAL = 35278848;

namespace pg8 {
#define PG8_LAS __attribute__((address_space(3)))
typedef unsigned short bf16_t;
typedef short bf16x8 __attribute__((ext_vector_type(8)));
typedef float f32x4 __attribute__((ext_vector_type(4)));
typedef float f32x2 __attribute__((ext_vector_type(2)));
typedef unsigned u32x4 __attribute__((ext_vector_type(4)));
typedef unsigned u32x2 __attribute__((ext_vector_type(2)));
constexpr int BM = 256, BK = 64, HALF = 128, HTB = HALF * BK * 2  , STAGE_BYTES = 8 * HTB, NXCD = 8, WGM = 8;

__host__ __device__ __forceinline__ int lds_byte(int r, int c) { const int st = (r >> 4) * 2 + (c >> 5), rr = r & 15, cc = c & 31, ob = rr * 64 + cc * 2; return st * 1024 + (ob ^ (((ob >> 9) & 1) << 5)); }
__host__ __device__ __forceinline__ void stage_rc(int b, int& R, int& C) { const int st = b / 1024, sb = b % 1024, swz = sb ^ (((sb >> 9) & 1) << 5); R = (st >> 1) * 16 + swz / 64; C = (st & 1) * 32 + (swz % 64) / 2; }
__host__ __device__ __forceinline__ int perm32(int rho) { const int n = rho >> 4, i = rho & 15; return 8 * (i >> 2) + 4 * n + (i & 3); }

struct Unit { int pm, pn; };
struct Gemm { const bf16_t* A; const bf16_t* Bt; int M, N, K, lda, ldb, gpan; size_t gstrideB; };

struct StaticOrder {
    int nM, nN, nwg, G, c;
    __host__ __device__ void init(int M, int N, int G_, int c_) { nM = M / BM; nN = N / BM; nwg = nM * nN; G = G_; c = c_; }
    __host__ __device__ bool next(int i, Unit& u) const {
        const long L = (long)i * G + c; if (L >= nwg) return false;
        int wgid = (int)L; { const int q = nwg / NXCD, r = nwg % NXCD, xcd = wgid % NXCD, off = wgid / NXCD; wgid = (xcd < r ? xcd * (q + 1) : r * (q + 1) + (xcd - r) * q) + off; }
        const int nig = WGM * nN, gid = wgid / nig, fm = gid * WGM, gsz = (nM - fm) < WGM ? (nM - fm) : WGM;
        u.pm = fm + ((wgid % nig) % gsz); u.pn = (wgid % nig) / gsz; return true;
    }
    __device__ __forceinline__ void a_ready(const Unit&) const {}
    __device__ __forceinline__ void done(const Unit&) const {}
};

__device__ __forceinline__ unsigned cvt_pk_bf16(float lo, float hi) { unsigned r; asm volatile("v_cvt_pk_bf16_f32 %0, %1, %2" : "=v"(r) : "v"(lo), "v"(hi)); return r; }
__device__ __forceinline__ float bf_lo(unsigned w) { return __uint_as_float(w << 16); }
__device__ __forceinline__ float bf_hi(unsigned w) { return __uint_as_float(w & 0xffff0000u); }
__device__ __forceinline__ float sigmoid_f(float z) { return __builtin_amdgcn_rcpf(1.0f + __builtin_amdgcn_exp2f(-1.4426950408889634f * z)); }
__device__ __forceinline__ float gelu_tanh(float x) { const float t = x * (1.0f + 0.044715f * x * x); return x * __builtin_amdgcn_rcpf(1.0f + __builtin_amdgcn_exp2f(-2.302208198f * t)); }

#define EPI_LOOP_AM for (int ai = 0; ai < 2; ++ai) _Pragma("unroll") for (int m = 0; m < 4; ++m)

template <int ACT  > struct EpiBf16 {
    static constexpr bool PERM = true, AFTER_DRAIN = false;
    bf16_t* O; int ldc;
    __device__ __forceinline__ void operator()(const f32x4 (&acc)[2][2][4][2], const Unit& u, int wr, int wc, int fr, int fq) const {
        const int row0 = u.pm * BM + wr * 64 + fr, col0 = u.pn * BM + wc * 32 + 8 * fq;
#pragma unroll
        EPI_LOOP_AM { bf16_t* rowp = O + (size_t)(row0 + ai * HALF + m * 16) * ldc + col0;
#pragma unroll
            for (int bj = 0; bj < 2; ++bj) { f32x4 v0 = acc[ai][bj][m][0], v1 = acc[ai][bj][m][1];
                if (ACT == 2) {
#pragma unroll
                    for (int e = 0; e < 4; ++e) { const float a = fmaxf(v0[e], 0.f), b = fmaxf(v1[e], 0.f); v0[e] = a * a; v1[e] = b * b; } }
                u32x4 w; w.x = cvt_pk_bf16(v0[0], v0[1]); w.y = cvt_pk_bf16(v0[2], v0[3]); w.z = cvt_pk_bf16(v1[0], v1[1]); w.w = cvt_pk_bf16(v1[2], v1[3]);
                *(u32x4*)(rowp + bj * HALF) = w; } }
    }
};
struct EpiInProj {
    static constexpr bool PERM = true, AFTER_DRAIN = false;
    bf16_t *QB, *KB, *VB, *UX, *US; float* out;
    __device__ __forceinline__ void operator()(const f32x4 (&acc)[2][2][4][2], const Unit& u, int wr, int wc, int fr, int fq) const {
        const int t = u.pn >> 1; const bool samp = u.pm >= 64;
        const int row0 = u.pm * BM + wr * 64 + fr, col0 = (u.pn & 1) * BM + wc * 32 + 8 * fq;
#pragma unroll
        EPI_LOOP_AM { const int row = row0 + ai * HALF + m * 16;
#pragma unroll
            for (int bj = 0; bj < 2; ++bj) { const int col = col0 + bj * HALF; f32x4 v0 = acc[ai][bj][m][0], v1 = acc[ai][bj][m][1];
                if (t == 1 || t == 2) {
                    float* dst = samp ? out + (t == 1 ? OFF_KS : OFF_VS) + (size_t)(row - MP) * AW + col : out + (t == 1 ? OFF_KP : OFF_VP) + (size_t)row * AW + col;
                    *(f32x4*)dst = v0; *(f32x4*)(dst + 4) = v1; }
                if (t == 0) { v0 = v0 * C2Q; v1 = v1 * C2Q; }
                u32x4 w; w.x = cvt_pk_bf16(v0[0], v0[1]); w.y = cvt_pk_bf16(v0[2], v0[3]); w.z = cvt_pk_bf16(v1[0], v1[1]); w.w = cvt_pk_bf16(v1[2], v1[3]);
                bf16_t* d;
                if (t == 0) d = QB + (size_t)row * AW + col; else if (t == 1) d = KB + (size_t)row * AW + col; else if (t == 2) d = VB + (size_t)row * AW + col;
                else if (!samp) d = UX + ((size_t)((col >> 4) * 1024 + (row >> 4)) * 384 + (row & 15) * 16 + (col & 15));
                else d = US + (size_t)(row - MP) * AW + col;
                *(u32x4*)d = w; } }
    }
};
struct EpiGlu {
    static constexpr bool PERM = true, AFTER_DRAIN = false;
    const bf16_t* ACT; bf16_t* MIX; const float* bias;
    __device__ __forceinline__ void operator()(const f32x4 (&acc)[2][2][4][2], const Unit& u, int wr, int wc, int fr, int fq) const {
        const int row0 = u.pm * BM + wr * 64 + fr, col0 = u.pn * BM + wc * 32 + 8 * fq;
#pragma unroll
        for (int bj = 0; bj < 2; ++bj) { const int col = col0 + bj * HALF; const f32x4 b0 = *(const f32x4*)(bias + col), b1 = *(const f32x4*)(bias + col + 4);
#pragma unroll
            EPI_LOOP_AM { const int row = row0 + ai * HALF + m * 16; const u32x4 a = *(const u32x4*)(ACT + (size_t)row * 512 + col);
                const f32x4 z0 = acc[ai][bj][m][0] + b0, z1 = acc[ai][bj][m][1] + b1;
                const float o0 = bf_lo(a.x) * sigmoid_f(z0[0]), o1 = bf_hi(a.x) * sigmoid_f(z0[1]), o2 = bf_lo(a.y) * sigmoid_f(z0[2]), o3 = bf_hi(a.y) * sigmoid_f(z0[3]);
                const float o4 = bf_lo(a.z) * sigmoid_f(z1[0]), o5 = bf_hi(a.z) * sigmoid_f(z1[1]), o6 = bf_lo(a.w) * sigmoid_f(z1[2]), o7 = bf_hi(a.w) * sigmoid_f(z1[3]);
                u32x4 w; w.x = cvt_pk_bf16(o0, o1); w.y = cvt_pk_bf16(o2, o3); w.z = cvt_pk_bf16(o4, o5); w.w = cvt_pk_bf16(o6, o7);
                *(u32x4*)(MIX + (size_t)row * DM_ + 512 + col) = w; } }
    }
};
struct EpiSsmB {
    static constexpr bool PERM = true, AFTER_DRAIN = false;
    const bf16_t* UX; bf16_t* ACT; const float* dskip;
    __device__ __forceinline__ void operator()(const f32x4 (&acc)[2][2][4][2], const Unit& u, int wr, int wc, int fr, int fq) const {
        const int g = u.pm >> 2, b = u.pm & 3;
#pragma unroll
        for (int bj = 0; bj < 2; ++bj) { const int col = bj * HALF + wc * 32 + 8 * fq, j = col >> 4, h0 = col & 15;
            const f32x4 d0 = *(const f32x4*)(dskip + g * 16 + h0), d1 = *(const f32x4*)(dskip + g * 16 + h0 + 4);
#pragma unroll
            EPI_LOOP_AM { const int c = ai * HALF + wr * 64 + m * 16 + fr;
                const u32x4 a = *(const u32x4*)(UX + (size_t)(u.pm * BM + c) * 384 + col);
                const f32x4 v0 = acc[ai][bj][m][0], v1 = acc[ai][bj][m][1];
                const float o0 = gelu_tanh(v0[0] + d0[0] * bf_lo(a.x)), o1 = gelu_tanh(v0[1] + d0[1] * bf_hi(a.x)), o2 = gelu_tanh(v0[2] + d0[2] * bf_lo(a.y)), o3 = gelu_tanh(v0[3] + d0[3] * bf_hi(a.y));
                const float o4 = gelu_tanh(v1[0] + d1[0] * bf_lo(a.z)), o5 = gelu_tanh(v1[1] + d1[1] * bf_hi(a.z)), o6 = gelu_tanh(v1[2] + d1[2] * bf_lo(a.w)), o7 = gelu_tanh(v1[3] + d1[3] * bf_hi(a.w));
                u32x4 w; w.x = cvt_pk_bf16(o0, o1); w.y = cvt_pk_bf16(o2, o3); w.z = cvt_pk_bf16(o4, o5); w.w = cvt_pk_bf16(o6, o7);
                *(u32x4*)(ACT + (size_t)(b * SEQ_ + c * 16 + j) * 512 + g * 16 + h0) = w; asm volatile("" ::: "memory"); } }
    }
};
template <int MODE> struct EpiF32 {
    static constexpr bool PERM = false, AFTER_DRAIN = false;
    const float* R; float* O; const float* bias; const bf16_t* PE;
    __device__ __forceinline__ void operator()(const f32x4 (&acc)[2][2][4][2], const Unit& u, int wr, int wc, int fr, int fq) const {
        const int row0 = u.pm * BM + wr * 64 + fr, col0 = u.pn * BM + wc * 32 + 4 * fq;
#pragma unroll
        for (int bj = 0; bj < 2; ++bj)
#pragma unroll
            for (int n = 0; n < 2; ++n) { const int col = col0 + bj * HALF + n * 16; f32x4 bv = (f32x4){0.f, 0.f, 0.f, 0.f}; if (MODE == 1) bv = *(const f32x4*)(bias + col);
#pragma unroll
                EPI_LOOP_AM { const size_t off = (size_t)(row0 + ai * HALF + m * 16) * DM_ + col; const f32x4 r = *(const f32x4*)(R + off); f32x4 o;
                    if (MODE == 0) o = r * ALPHA + acc[ai][bj][m][n];
                    else if (MODE == 1) { const u32x2 pw = *(const u32x2*)(PE + off); const f32x4 z = acc[ai][bj][m][n] + bv;
                        o[0] = r[0] * ALPHA + sigmoid_f(z[0]) * bf_lo(pw.x); o[1] = r[1] * ALPHA + sigmoid_f(z[1]) * bf_hi(pw.x); o[2] = r[2] * ALPHA + sigmoid_f(z[2]) * bf_lo(pw.y); o[3] = r[3] * ALPHA + sigmoid_f(z[3]) * bf_hi(pw.y); }
                    else o = acc[ai][bj][m][n] + r;
                    *(f32x4*)(O + off) = o; } }
    }
};
struct EpiSsmA {
    static constexpr bool PERM = false, AFTER_DRAIN = true;
    bf16_t* UX; float* out; const float *lam_re, *lam_im, *log_dt;
    __device__ __forceinline__ void fused(f32x4 (&acc)[2][2][4][2], const Unit& u, int wr, int wc, int fr, int fq, PG8_LAS unsigned char* lds, int wid, int lane) const;
};

template <class Epi, class Sched, bool ALIGN_EPI = false>
__device__ __forceinline__ void gemm_phase(PG8_LAS unsigned char* lds, const Gemm g, const Sched& S, const Epi& E) {
    const int tid = threadIdx.x, wid = __builtin_amdgcn_readfirstlane(tid >> 6), lane = tid & 63, wr = wid >> 2, wc = wid & 3, fr = lane & 15, fq = lane >> 4;
    const int K = g.K, nt = K / BK;
    unsigned voffA[2], voffB[2];
#pragma unroll
    for (int i = 0; i < 2; ++i) { int R, C; stage_rc(tid * 16 + i * 8192, R, C); const int Rb = Epi::PERM ? ((R & ~31) + perm32(R & 31)) : R;
        voffA[i] = (unsigned)(R * g.lda + C) * 2u; voffB[i] = (unsigned)(Rb * g.ldb + C) * 2u; }
    const size_t kstep = (size_t)(BK * 2);
    const size_t hstepA = (size_t)HALF * g.lda * 2, hstepB = (size_t)HALF * g.ldb * 2;
    const size_t tstepA = 2 * hstepA, tstepB = 2 * hstepB;
    const unsigned ldsw = (unsigned)wid * 1024u;
    const int aoff = lds_byte(wr * 64 + fr, fq * 8), boff = lds_byte(wc * 32 + fr, fq * 8);
#define PG8_SA(b, h) (((b) * 2 + (h)) * HTB)
#define PG8_SB(b, h) ((4 + (b) * 2 + (h)) * HTB)
#define PG8_STAGE(bufoff, gbase, voff) do { _Pragma("unroll") for (int _i = 0; _i < 2; ++_i) \
        __builtin_amdgcn_global_load_lds((const unsigned*)((const char*)(gbase) + (voff)[_i]), (PG8_LAS unsigned*)(lds + (bufoff) + ldsw + _i * 8192), 16, 0, 0); } while (0)
#define PG8_LDA(dst, b, h) do { _Pragma("unroll") for (int m = 0; m < 4; ++m) _Pragma("unroll") for (int k = 0; k < 2; ++k) dst[m][k] = *(const PG8_LAS bf16x8*)(lds + PG8_SA(b, h) + aoff + m * 2048 + k * 1024); } while (0)
#define PG8_LDB(dst, b, h) do { _Pragma("unroll") for (int n = 0; n < 2; ++n) _Pragma("unroll") for (int k = 0; k < 2; ++k) dst[n][k] = *(const PG8_LAS bf16x8*)(lds + PG8_SB(b, h) + boff + n * 2048 + k * 1024); } while (0)
#define PG8_MMA(ai, bj, At, Bt) do { __builtin_amdgcn_s_setprio(1); _Pragma("unroll") for (int m = 0; m < 4; ++m) _Pragma("unroll") for (int n = 0; n < 2; ++n) _Pragma("unroll") for (int k = 0; k < 2; ++k) \
        acc[ai][bj][m][n] = __builtin_amdgcn_mfma_f32_16x16x32_bf16(Bt[n][k], At[m][k], acc[ai][bj][m][n], 0, 0, 0); __builtin_amdgcn_s_setprio(0); } while (0)
#define PG8_WAIT_V(n) asm volatile("s_waitcnt vmcnt(" #n ")" ::: "memory")
#define PG8_WAIT_L(n) asm volatile("s_waitcnt lgkmcnt(" #n ")" ::: "memory")
#define PG8_BAR __builtin_amdgcn_s_barrier()
#define PG8_SCHED __builtin_amdgcn_sched_barrier(0)
#define PG8_ABASE(u_) ((const char*)g.A + (size_t)(u_).pm * tstepA)
#define PG8_BBASE(u_) ((const char*)g.Bt + (size_t)(u_).pn * tstepB + (g.gpan ? (size_t)((u_).pm / g.gpan) * g.gstrideB : (size_t)0))
    Unit cur, nxt; int ui = 0;
    if (!S.next(0, cur)) return;
    f32x4 acc[2][2][4][2];
#pragma unroll
    for (int a = 0; a < 2; ++a)
#pragma unroll
        for (int b = 0; b < 2; ++b)
#pragma unroll
            for (int m = 0; m < 4; ++m)
#pragma unroll
                for (int n = 0; n < 2; ++n) acc[a][b][m][n] = (f32x4){0.f, 0.f, 0.f, 0.f};
    bf16x8 At[4][2], B0[2][2], B1[2][2];
    const char* cA = PG8_ABASE(cur); const char* cB = PG8_BBASE(cur);
    S.a_ready(cur);
    PG8_STAGE(PG8_SB(0, 0), cB, voffB); PG8_STAGE(PG8_SB(0, 1), cB + hstepB, voffB); PG8_STAGE(PG8_SA(0, 0), cA, voffA); PG8_STAGE(PG8_SA(0, 1), cA + hstepA, voffA);
    if (wr == 1) PG8_BAR;
    PG8_WAIT_V(2); PG8_BAR;
    PG8_STAGE(PG8_SB(1, 0), cB + kstep, voffB); PG8_STAGE(PG8_SA(1, 0), cA + kstep, voffA); PG8_STAGE(PG8_SB(1, 1), cB + hstepB + kstep, voffB);
    PG8_WAIT_V(6); PG8_BAR;
    for (;;) {
        const bool has_next = S.next(ui + 1, nxt);
        const char* nA = has_next ? PG8_ABASE(nxt) : cA; const char* nB = has_next ? PG8_BBASE(nxt) : cB;
#pragma unroll 1
        for (int t = 0; t < nt; t += 2) {
            const bool last = (t == nt - 2);
            const char* a1 = cA + (size_t)(t + 1) * kstep;
            const char* a2 = last ? nA : cA + (size_t)(t + 2) * kstep; const char* b2 = last ? nB : cB + (size_t)(t + 2) * kstep;
            const char* a3 = a2 + kstep; const char* b3 = b2 + kstep;
            if (last && has_next) S.a_ready(nxt);
            PG8_LDB(B0, 0, 0); PG8_LDB(B1, 0, 1); PG8_SCHED; PG8_LDA(At, 0, 0); PG8_STAGE(PG8_SA(1, 1), a1 + hstepA, voffA);
            PG8_WAIT_V(8); PG8_WAIT_L(0); PG8_BAR; PG8_MMA(0, 0, At, B0); PG8_MMA(0, 1, At, B1); PG8_BAR; PG8_SCHED;
            PG8_LDA(At, 0, 1); PG8_STAGE(PG8_SB(0, 0), b2, voffB); PG8_STAGE(PG8_SB(0, 1), b2 + hstepB, voffB); PG8_STAGE(PG8_SA(0, 0), a2, voffA);
            PG8_WAIT_V(8); PG8_WAIT_L(0); PG8_BAR; PG8_MMA(1, 0, At, B0); PG8_MMA(1, 1, At, B1); PG8_BAR; PG8_SCHED;
            PG8_LDB(B0, 1, 0); PG8_LDB(B1, 1, 1); PG8_SCHED; PG8_LDA(At, 1, 0); PG8_STAGE(PG8_SA(0, 1), a2 + hstepA, voffA);
            PG8_WAIT_V(8); PG8_WAIT_L(0); PG8_BAR; PG8_MMA(0, 0, At, B0); PG8_MMA(0, 1, At, B1); PG8_BAR; PG8_SCHED;
            PG8_LDA(At, 1, 1); PG8_STAGE(PG8_SB(1, 0), b3, voffB); PG8_STAGE(PG8_SB(1, 1), b3 + hstepB, voffB); PG8_STAGE(PG8_SA(1, 0), a3, voffA);
            PG8_WAIT_V(8); PG8_WAIT_L(0); PG8_BAR; PG8_MMA(1, 0, At, B0); PG8_MMA(1, 1, At, B1); PG8_BAR; PG8_SCHED;
        }
        if constexpr (ALIGN_EPI) { if (wr == 0) PG8_BAR; }
        if constexpr (!Epi::AFTER_DRAIN) { E(acc, cur, wr, wc, fr, fq); S.done(cur); }
        if (!has_next) break;
#pragma unroll
        for (int a = 0; a < 2; ++a)
#pragma unroll
            for (int b = 0; b < 2; ++b)
#pragma unroll
                for (int m = 0; m < 4; ++m)
#pragma unroll
                    for (int n = 0; n < 2; ++n) acc[a][b][m][n] = (f32x4){0.f, 0.f, 0.f, 0.f};
        cur = nxt; cA = nA; cB = nB; ++ui;
        if constexpr (ALIGN_EPI) { if (wr == 1) PG8_BAR; }
    }
    PG8_WAIT_V(0);
    if constexpr (!ALIGN_EPI) { if (wr == 0) PG8_BAR; }
    PG8_BAR;
    if constexpr (Epi::AFTER_DRAIN) { E.fused(acc, cur, wr, wc, fr, fq, lds, wid, lane); S.done(cur); }
#undef PG8_SA
#undef PG8_SB
#undef PG8_STAGE
#undef PG8_LDA
#undef PG8_LDB
#undef PG8_MMA
#undef PG8_WAIT_V
#undef PG8_WAIT_L
#undef PG8_BAR
#undef PG8_SCHED
#undef PG8_ABASE
#undef PG8_BBASE
}
}

#include <hip/hip_bf16.h>
#include <cmath>
namespace attn_body {
using bf16=__hip_bfloat16;
using bf16x8=__attribute__((ext_vector_type(8)))short;
using s16x4=__attribute__((ext_vector_type(4)))short;
using f32x16=__attribute__((ext_vector_type(16)))float;
using u32x4=__attribute__((ext_vector_type(4)))unsigned;
constexpr int BATCH=4,NHEAD=8,SEQ=4096,D=64,DM=NHEAD*D,OP=1024;
constexpr int NW=8,QBLK=32,QB=QBLK*NW,KVBLK=64,NQB=SEQ/QB;
constexpr int ATTN_PITCH=DM, ATTN_UNIT_ROWS=QB;
__device__ __forceinline__ int crow(int r,int hi){return (r&3)+8*(r>>2)+4*hi;}
#define SBAR() __builtin_amdgcn_sched_barrier(0)
__device__ __forceinline__ void cmask(f32x16&p0,f32x16&p1,int jb,int qrel,int hi){
  const float NEG=-INFINITY; int kb=64*jb+4*hi;
  #pragma unroll
  for(int r=0;r<16;++r){int kv=kb+(r&3)+8*(r>>2); if(kv>qrel)p0[r]=NEG; if(kv+32>qrel)p1[r]=NEG;}
}

constexpr int NSLOT=3, SLOTB=8192;
constexpr int LDS_K=0, LDS_V=NSLOT*SLOTB, LDS_WS=2*NSLOT*SLOTB, LDS_OST=LDS_WS+NW*64*4, LDS_BYTES=LDS_OST+NW*4096, LDS_CB=LDS_BYTES, LDS_TOTAL=LDS_CB+SEQ*4;
constexpr float C2=0.125f*1.4426950408889634f;
__device__ __forceinline__ void glds16(const void*gsrc,unsigned lds_dst){unsigned keep;
  asm volatile("s_mov_b32 %0, m0\n\ts_mov_b32 m0, %2\n\ts_nop 0\n\tglobal_load_lds_dwordx4 %1, off\n\ts_mov_b32 m0, %0":"=&s"(keep):"v"(gsrc),"s"(lds_dst):"memory");}
__device__ __forceinline__ float max3f(float a,float b,float c){float r;asm("v_max3_f32 %0, %1, %2, %3":"=v"(r):"v"(a),"v"(b),"v"(c));return r;}
__device__ __forceinline__ float max2f(float a,float b){float r;asm("v_max_f32_e32 %0, %1, %2":"=v"(r):"v"(a),"v"(b));return r;}
__device__ __forceinline__ float fadd_s(float a,float b){float r;asm("v_add_f32_e32 %0, %1, %2":"=v"(r):"v"(a),"v"(b));return r;}
__device__ __forceinline__ float fsub_s(float a,float b){float r;asm("v_sub_f32_e32 %0, %1, %2":"=v"(r):"v"(a),"v"(b));return r;}
typedef float f32x2_t __attribute__((ext_vector_type(2))); typedef __bf16 bf16x2_t __attribute__((ext_vector_type(2)));
__device__ __forceinline__ unsigned cvtpk_s(float lo,float hi){f32x2_t v={lo,hi};bf16x2_t b=__builtin_convertvector(v,bf16x2_t);return __builtin_bit_cast(unsigned,b);}
#define WAIT_BAR(N) asm volatile("s_waitcnt vmcnt(" #N ") lgkmcnt(0)\n\ts_barrier":::"memory")

__device__ __forceinline__ void qkt(f32x16&p0,f32x16&p1,const char*Kslot,const bf16x8*qr,int r32,int hi){
  const char*kb=Kslot+hi*1024+r32*16;
  #pragma unroll
  for(int d0=0;d0<4;++d0){
    const bf16x8 b0=*reinterpret_cast<const bf16x8*>(kb+d0*2048);
    const bf16x8 b1=*reinterpret_cast<const bf16x8*>(kb+d0*2048+512);
    {p0=__builtin_amdgcn_mfma_f32_32x32x16_bf16(b0,qr[d0],p0,0,0,0);p1=__builtin_amdgcn_mfma_f32_32x32x16_bf16(b1,qr[d0],p1,0,0,0);}}
}
typedef __attribute__((address_space(3))) const char* lds_cptr;
typedef short v4i16_t __attribute__((ext_vector_type(4)));
__device__ __forceinline__ void kload8(bf16x8*kf,lds_cptr kp){
  kf[0]=*(const __attribute__((address_space(3))) bf16x8*)(kp);      kf[1]=*(const __attribute__((address_space(3))) bf16x8*)(kp+512);
  kf[2]=*(const __attribute__((address_space(3))) bf16x8*)(kp+2048); kf[3]=*(const __attribute__((address_space(3))) bf16x8*)(kp+2560);
  kf[4]=*(const __attribute__((address_space(3))) bf16x8*)(kp+4096); kf[5]=*(const __attribute__((address_space(3))) bf16x8*)(kp+4608);
  kf[6]=*(const __attribute__((address_space(3))) bf16x8*)(kp+6144); kf[7]=*(const __attribute__((address_space(3))) bf16x8*)(kp+6656);
}
__device__ __forceinline__ void kload2(bf16x8*kf,lds_cptr kp,int j){ kf[2*j]=*(const __attribute__((address_space(3))) bf16x8*)(kp+j*2048); kf[2*j+1]=*(const __attribute__((address_space(3))) bf16x8*)(kp+j*2048+512); }
__device__ __forceinline__ s16x4 vtr(lds_cptr p){ return __builtin_bit_cast(s16x4,__builtin_amdgcn_ds_read_tr16_b64_v4i16((__attribute__((address_space(3))) v4i16_t*)p)); }
__device__ __forceinline__ float rowmax(const f32x16&p0,const f32x16&p1){
  float a=max3f(p0[0],p0[1],p1[0]),b=max3f(p0[2],p0[3],p1[1]);a=max3f(a,p1[2],p1[3]);
  #pragma unroll
  for(int r=4;r<16;r+=4){a=max3f(a,p0[r],p0[r+1]);b=max3f(b,p0[r+2],p0[r+3]);a=max3f(a,p1[r],p1[r+1]);b=max3f(b,p1[r+2],p1[r+3]);}
  const float m=max2f(a,b);
  auto rr=__builtin_amdgcn_permlane32_swap(__float_as_uint(m),__float_as_uint(m),false,false);
  return max2f(__uint_as_float(rr[0]),__uint_as_float(rr[1]));
}
__device__ __forceinline__ void pv(f32x16*o,int vb,bf16x8 pa0,bf16x8 pa1,bf16x8 pa2,bf16x8 pa3){
  #pragma unroll
  for(int d0=0;d0<2;++d0){s16x4 lo[4],hi[4];
    #pragma unroll
    for(int ks=0;ks<4;++ks){
      asm volatile("ds_read_b64_tr_b16 %0,%1 offset:%c2":"=&v"(lo[ks]):"v"(vb),"i"(d0*4096+ks*1024):"memory");
      asm volatile("ds_read_b64_tr_b16 %0,%1 offset:%c2":"=&v"(hi[ks]):"v"(vb),"i"(d0*4096+ks*1024+512):"memory");}
    asm volatile("s_waitcnt lgkmcnt(0)":::"memory");SBAR();
    #define PK(k) (bf16x8){lo[k][0],lo[k][1],lo[k][2],lo[k][3],hi[k][0],hi[k][1],hi[k][2],hi[k][3]}
    o[d0]=__builtin_amdgcn_mfma_f32_32x32x16_bf16(pa0,PK(0),o[d0],0,0,0);
    o[d0]=__builtin_amdgcn_mfma_f32_32x32x16_bf16(pa1,PK(1),o[d0],0,0,0);
    o[d0]=__builtin_amdgcn_mfma_f32_32x32x16_bf16(pa2,PK(2),o[d0],0,0,0);
    o[d0]=__builtin_amdgcn_mfma_f32_32x32x16_bf16(pa3,PK(3),o[d0],0,0,0);
    #undef PK
  }
}

#ifndef ATTN_STORE16
#define ATTN_STORE16(p,v) (*(u32x4*)(p)=(v))
#endif
template<int THRL> __device__ __forceinline__ void attn_unit(int b,int h,int qb,const bf16*Q,const bf16*__restrict__ K,const bf16*__restrict__ V,bf16*O,const float*cneg,char*shm){
  const int tid=threadIdx.x,lane=tid&63,r32=lane&31,hi=lane>>5; const int wid=__builtin_amdgcn_readfirstlane(tid>>6);
  const long rowbase=(long)b*SEQ; const int q0=qb*QB;
  const bf16*Qw=Q+(rowbase+q0+wid*QBLK)*DM+h*D;
  const bf16*Kh=K+rowbase*DM+h*D,*Vh=V+rowbase*DM+h*D;
  const unsigned lds0=(unsigned)(uintptr_t)shm;
  float*wsf=(float*)(shm+LDS_WS)+wid*64;
  const bf16*ksrc=Kh+(long)lane*DM+wid*8;
  const bf16*vsrc=Vh+(long)(16*(wid&3)+(lane>>2))*DM+(wid>>2)*32+(lane&3)*8;
  const unsigned kdst=lds0+LDS_K+wid*1024, vdst=lds0+LDS_V+wid*1024;
  #define DMA_K(t,slot) glds16(ksrc+(long)(t)*KVBLK*DM,(unsigned)__builtin_amdgcn_readfirstlane(kdst+(slot)))
  #define DMA_V(t,slot) glds16(vsrc+(long)(t)*KVBLK*DM,(unsigned)__builtin_amdgcn_readfirstlane(vdst+(slot)))
  const int vb0=(int)(lds0+LDS_V)+((lane>>4)&1)*32+(lane&3)*8+(4*hi+((lane&15)>>2))*64;
  const char*Kbase=shm+LDS_K; bf16x8 kf[8];
  const lds_cptr shm3=(lds_cptr)shm; const lds_cptr kp0=shm3+LDS_K+hi*1024+r32*16; const lds_cptr vp0=shm3+LDS_V+((lane>>4)&1)*32+(lane&3)*8+(4*hi+((lane&15)>>2))*64;
  { typedef float f32x4c __attribute__((ext_vector_type(4))); const f32x4c*csrc=(const f32x4c*)(cneg+(long)(b*NHEAD+h)*SEQ); __attribute__((address_space(3))) f32x4c*cdst=(__attribute__((address_space(3))) f32x4c*)(shm3+LDS_CB); const int n4=(q0+QB)/4; for(int i_=tid;i_<n4;i_+=NW*64)cdst[i_]=csrc[i_]; }
  typedef float f32x4b __attribute__((ext_vector_type(4))); const __attribute__((address_space(3))) f32x4b*cbl=(const __attribute__((address_space(3))) f32x4b*)(shm3+LDS_CB)+hi;
  #define BIAS(P0,P1,t) do{ const __attribute__((address_space(3))) f32x4b*cb_=cbl+16*(t); _Pragma("unroll") for(int g_=0;g_<4;++g_){ const f32x4b a_=cb_[2*g_], b_=cb_[2*g_+8]; P0[4*g_]=a_[0]-mhat;P0[4*g_+1]=a_[1]-mhat;P0[4*g_+2]=a_[2]-mhat;P0[4*g_+3]=a_[3]-mhat; P1[4*g_]=b_[0]-mhat;P1[4*g_+1]=b_[1]-mhat;P1[4*g_+2]=b_[2]-mhat;P1[4*g_+3]=b_[3]-mhat; } }while(0)
  const int NT=(q0+QB)/KVBLK;
  DMA_K(0,0);DMA_V(0,0);DMA_K(1,SLOTB);
  bf16x8 qr[4];
  #pragma unroll
  for(int d0=0;d0<4;++d0)qr[d0]=*reinterpret_cast<const bf16x8*>(&Qw[(long)r32*DM+d0*16+hi*8]);
  float mhat=0.f,l_reg=0.f;f32x16 o[2];o[0]=f32x16{};o[1]=f32x16{};
  const int qrel=wid*QBLK+r32;
  #define CMASK(P0,P1,t) do{int jb_=(t)-(NT-4); if(jb_>=0)cmask(P0,P1,jb_,qrel,hi);}while(0)
  bool resc=false;
  #define START(P0,P1) do{ const float rm=rowmax(P0,P1); resc=false; \
    { const float dl=rm; mhat=fadd_s(mhat,dl); \
      _Pragma("unroll") for(int r=0;r<16;++r){P0[r]=fsub_s(P0[r],dl);P1[r]=fsub_s(P1[r],dl);} \
      } \
    _Pragma("unroll") for(int r=0;r<16;++r)P0[r]=__builtin_amdgcn_exp2f(P0[r]); }while(0)
  #define RESC() do{ if(resc){ asm volatile("s_waitcnt lgkmcnt(0)":::"memory"); \
      _Pragma("unroll") for(int d_=0;d_<2;++d_) _Pragma("unroll") for(int r=0;r<16;++r)o[d_][r]*=wsf[crow(r,hi)]; } }while(0)
  f32x16 pA0,pA1,pB0,pB1;
  int sl_prev=0,sl_cur=0,sl_next=SLOTB;
  #define ROT() do{sl_prev=sl_cur;sl_cur=sl_next;sl_next=(sl_next==(NSLOT-1)*SLOTB)?0:sl_next+SLOTB;}while(0)
  DMA_K(2,2*SLOTB);
  WAIT_BAR(3);
  BIAS(pA0,pA1,0);qkt(pA0,pA1,Kbase,qr,r32,hi);asm volatile("s_nop 15\n\ts_nop 7":"+v"(pA0),"+v"(pA1));CMASK(pA0,pA1,0);
  START(pA0,pA1);
  _Pragma("unroll") for(int r=0;r<16;++r)pA1[r]=__builtin_amdgcn_exp2f(pA1[r]);
  WAIT_BAR(0);
  DMA_K(3,0);DMA_V(1,SLOTB);
  ROT();
  kload8(kf,kp0+sl_cur);
  WAIT_BAR(2);
  s16x4 vlo[8],vhi[8]; u32x4 pw0,pw1,pw2,pw3;
  #define PKW(P,B) cvtpk_s(P[B],P[B+1])
  #define PAF(k) __builtin_bit_cast(bf16x8,pw##k)
  #define VFR(i) (bf16x8){vlo[i][0],vlo[i][1],vlo[i][2],vlo[i][3],vhi[i][0],vhi[i][1],vhi[i][2],vhi[i][3]}
  #define PIN(x) asm volatile("":"+v"(x))
  #define MX3(a,b,c) __builtin_fmaxf(__builtin_fmaxf((a),(b)),(c))
  #define GAPA(MF,A0,A1,A2,A3,W0,W1,PW) do{ MF; sacc+=A0; sacc+=A1; sacc+=A2; sacc+=A3; PIN(sacc); W0; W1; PIN(PW); SBAR(); }while(0)
  #define EX(v) __builtin_amdgcn_exp2f(v)
  #define GAPB(MF,X,B) do{ MF; X[B]=EX(X[B]); X[B+1]=EX(X[B+1]); X[B+2]=EX(X[B+2]); X[B+3]=EX(X[B+3]); PIN(X); SBAR(); }while(0)
  #define VRD(i) do{ vlo[i]=vtr(vp_+(((i)>>2)*4096+((i)&3)*1024)); vhi[i]=vtr(vp_+(((i)>>2)*4096+((i)&3)*1024+512)); }while(0)
  #define KRD(G,j) do{ if(G){ kload2(kf,kp0+sl_next,j); SBAR(); } }while(0)
  #define STEP(C0,C1,P0,P1,t,GK,GV,GL) do{ SBAR(); BIAS(C0,C1,t); SBAR(); \
    const lds_cptr vp_=vp0+sl_prev; \
    VRD(0); SBAR(); float sacc=(P0[0]+P0[1]); \
    GAPA(C0=__builtin_amdgcn_mfma_f32_32x32x16_bf16(kf[0],qr[0],C0,0,0,0), P0[2],P0[3],P0[4],P0[5],     pw0[0]=PKW(P0,0), pw0[1]=PKW(P0,2), pw0); \
    VRD(4); SBAR(); GAPA(C1=__builtin_amdgcn_mfma_f32_32x32x16_bf16(kf[1],qr[0],C1,0,0,0), P0[6],P0[7],P0[8],P0[9],     pw0[2]=PKW(P0,4), pw0[3]=PKW(P0,6), pw0); \
    VRD(1); SBAR(); GAPA(C0=__builtin_amdgcn_mfma_f32_32x32x16_bf16(kf[2],qr[1],C0,0,0,0),   P0[10],P0[11],P0[12],P0[13], pw1[0]=PKW(P0,8), pw1[1]=PKW(P0,10), pw1); \
    VRD(5); SBAR(); GAPA(C1=__builtin_amdgcn_mfma_f32_32x32x16_bf16(kf[3],qr[1],C1,0,0,0),   P0[14],P0[15],P1[0],P1[1],   pw1[2]=PKW(P0,12),pw1[3]=PKW(P0,14), pw1); \
    VRD(2); SBAR(); GAPA(C0=__builtin_amdgcn_mfma_f32_32x32x16_bf16(kf[4],qr[2],C0,0,0,0),   P1[2],P1[3],P1[4],P1[5],     pw2[0]=PKW(P1,0), pw2[1]=PKW(P1,2), pw2); \
    VRD(6); SBAR(); GAPA(C1=__builtin_amdgcn_mfma_f32_32x32x16_bf16(kf[5],qr[2],C1,0,0,0),   P1[6],P1[7],P1[8],P1[9],     pw2[2]=PKW(P1,4), pw2[3]=PKW(P1,6), pw2); \
    VRD(3); SBAR(); GAPA(C0=__builtin_amdgcn_mfma_f32_32x32x16_bf16(kf[6],qr[3],C0,0,0,0),   P1[10],P1[11],P1[12],P1[13], pw3[0]=PKW(P1,8), pw3[1]=PKW(P1,10), pw3); \
    VRD(7); SBAR(); GAPA(C1=__builtin_amdgcn_mfma_f32_32x32x16_bf16(kf[7],qr[3],C1,0,0,0),   P1[14],P1[15],0.f,0.f,       pw3[2]=PKW(P1,12),pw3[3]=PKW(P1,14), pw3); \
    l_reg+=sacc; \
    if(GK){DMA_K((t)+3,sl_cur);} if(GV){DMA_V((t)+1,sl_next);} \
    CMASK(C0,C1,t); \
    { float a=MX3(C0[0],C0[1],C1[0]),b=MX3(C0[2],C0[3],C1[1]); a=MX3(a,C1[2],C1[3]); \
      _Pragma("unroll") for(int r=4;r<16;r+=4){a=MX3(a,C0[r],C0[r+1]);b=MX3(b,C0[r+2],C0[r+3]);a=MX3(a,C1[r],C1[r+1]);b=MX3(b,C1[r+2],C1[r+3]);} \
      float rm=__builtin_fmaxf(a,b); { auto rr=__builtin_amdgcn_permlane32_swap(__float_as_uint(rm),__float_as_uint(rm),false,false); rm=__builtin_fmaxf(__uint_as_float(rr[0]),__uint_as_float(rr[1])); } \
      resc=false; \
      if(__builtin_expect(__any(rm>(float)THRL),0)){ const float dl=__builtin_fmaxf(rm,0.f); mhat+=dl; \
        _Pragma("unroll") for(int r=0;r<16;++r){C0[r]-=dl;C1[r]-=dl;} \
        const float f=__builtin_amdgcn_exp2f(-dl); l_reg*=f; if(hi==0)wsf[r32]=f; resc=true; } } \
    SBAR(); \
    GAPB(o[0]=__builtin_amdgcn_mfma_f32_32x32x16_bf16(PAF(0),VFR(0),o[0],0,0,0), C0,0); \
    GAPB(o[1]=__builtin_amdgcn_mfma_f32_32x32x16_bf16(PAF(0),VFR(4),o[1],0,0,0), C0,4); \
    KRD(GL,0); GAPB(o[0]=__builtin_amdgcn_mfma_f32_32x32x16_bf16(PAF(1),VFR(1),o[0],0,0,0), C0,8); \
    KRD(GL,1); GAPB(o[1]=__builtin_amdgcn_mfma_f32_32x32x16_bf16(PAF(1),VFR(5),o[1],0,0,0), C0,12); \
    KRD(GL,2); GAPB(o[0]=__builtin_amdgcn_mfma_f32_32x32x16_bf16(PAF(2),VFR(2),o[0],0,0,0), C1,0); \
    KRD(GL,3); GAPB(o[1]=__builtin_amdgcn_mfma_f32_32x32x16_bf16(PAF(2),VFR(6),o[1],0,0,0), C1,4); \
    GAPB(o[0]=__builtin_amdgcn_mfma_f32_32x32x16_bf16(PAF(3),VFR(3),o[0],0,0,0), C1,8); \
    GAPB(o[1]=__builtin_amdgcn_mfma_f32_32x32x16_bf16(PAF(3),VFR(7),o[1],0,0,0), C1,12); \
    }while(0)
  int t=1;
  #undef CMASK
  #define CMASK(P0,P1,t) do{}while(0)
  for(;t+5<NT;t+=2){
    STEP(pB0,pB1,pA0,pA1,t,true,true,true);     WAIT_BAR(2); RESC(); ROT();
    STEP(pA0,pA1,pB0,pB1,t+1,true,true,true);   WAIT_BAR(2); RESC(); ROT();
  }
  #undef CMASK
  #define CMASK(P0,P1,t) do{int jb_=(t)-(NT-4); if(jb_>=0)cmask(P0,P1,jb_,qrel,hi);}while(0)
  #define ENDW(tt) do{ if((tt)+3<NT){WAIT_BAR(2);} else if((tt)+2<NT){WAIT_BAR(1);} else {WAIT_BAR(0);} }while(0)
  for(;t+1<NT;t+=2){
    STEP(pB0,pB1,pA0,pA1,t,(t+3<NT),(t+1<NT),(t+1<NT));       ENDW(t);   RESC(); ROT();
    STEP(pA0,pA1,pB0,pB1,t+1,(t+4<NT),(t+2<NT),(t+2<NT));     ENDW(t+1); RESC(); ROT();
  }
  STEP(pB0,pB1,pA0,pA1,NT-1,false,false,false); RESC();
  { float sacc=pB0[0]+pB0[1]; _Pragma("unroll") for(int r=2;r<16;++r)sacc+=pB0[r]; _Pragma("unroll") for(int r=0;r<16;++r)sacc+=pB1[r]; l_reg+=sacc;
    pw0=(u32x4){PKW(pB0,0),PKW(pB0,2),PKW(pB0,4),PKW(pB0,6)};pw1=(u32x4){PKW(pB0,8),PKW(pB0,10),PKW(pB0,12),PKW(pB0,14)};pw2=(u32x4){PKW(pB1,0),PKW(pB1,2),PKW(pB1,4),PKW(pB1,6)};pw3=(u32x4){PKW(pB1,8),PKW(pB1,10),PKW(pB1,12),PKW(pB1,14)};
    SBAR(); pv(o,vb0+sl_cur,PAF(0),PAF(1),PAF(2),PAF(3)); }
  #undef PKW
  #undef PAF
  #undef VFR
  #undef PIN
  #undef MX3
  #undef GAPA
  #undef GAPB
  #undef EX
  #undef VRD
  #undef KRD
  #undef STEP
  #undef ENDW
  {auto rr=__builtin_amdgcn_permlane32_swap(__float_as_uint(l_reg),__float_as_uint(l_reg),false,false);l_reg=__uint_as_float(rr[0])+__uint_as_float(rr[1]);}
  if(hi==0)wsf[32+r32]=l_reg;asm volatile("s_waitcnt lgkmcnt(0)":::"memory");
  float rli[16];
  #pragma unroll
  for(int r=0;r<16;++r)rli[r]=__builtin_amdgcn_rcpf(wsf[32+crow(r,hi)]);
  bf16*Ow=O+(rowbase+q0+wid*QBLK)*OP+h*D;
  { bf16*stg=(bf16*)(shm+LDS_OST)+wid*2048;
    #pragma unroll
    for(int r=0;r<16;++r){const int orow=crow(r,hi);
      #pragma unroll
      for(int d0=0;d0<2;++d0)stg[orow*64+d0*32+r32]=__float2bfloat16(o[d0][r]*rli[r]);}
    asm volatile("s_waitcnt lgkmcnt(0)":::"memory");
    #pragma unroll
    for(int i=0;i<4;++i){const int row=i*8+(lane>>3),ch=lane&7; const u32x4 v=*(const u32x4*)(stg+row*64+ch*8); ATTN_STORE16(Ow+(long)row*OP+ch*8,v);} }
  asm volatile("s_waitcnt lgkmcnt(0)\n\ts_barrier":::"memory");
  #undef DMA_K
  #undef DMA_V
  #undef BIAS
  #undef CMASK
  #undef START
  #undef RESC
  #undef ROT
}
constexpr int ATTN_LDS_BYTES=LDS_TOTAL;
struct AttnTensors { const bf16* Q; const bf16* K; const bf16* V; bf16* O; const float* cneg; };
struct AttnUnit { int bh; int qb; };
struct StaticOrder {
  int vcu;
  __device__ __forceinline__ explicit StaticOrder(int grid,int block):vcu((block%8)*(grid/8)+block/8){}
  __device__ __forceinline__ bool next(int i,AttnUnit&u)const{ if(i>=2)return false; const int s=vcu&7; u.bh=vcu>>3; u.qb=(i==0)?15-s:s; return true; }
  __device__ __forceinline__ void a_ready(const AttnUnit&)const{}
  __device__ __forceinline__ void done(const AttnUnit&)const{}
};
template<class Sched,int THRL=8> __device__ __forceinline__ void attn_phase(char*lds,const AttnTensors&T,const Sched&S){
  AttnUnit u;
  for(int i=0;S.next(i,u);++i){ S.a_ready(u); attn_unit<THRL>(u.bh/NHEAD,u.bh%NHEAD,u.qb,T.Q,T.K,T.V,T.O,T.cneg,lds); S.done(u); }
}
#undef SBAR
#undef WAIT_BAR
}


constexpr int NWAVES = 8;
#ifndef MK_N_LAUNCHES
#define MK_N_LAUNCHES 10
#endif
constexpr int PER_PHASE = 10;
constexpr int N_LAUNCHES = MK_N_LAUNCHES;
static_assert(N_LAUNCHES == 1 || N_LAUNCHES == PER_PHASE, "MK_N_LAUNCHES is 1 or PER_PHASE");

constexpr size_t MiB = 1u << 20;
constexpr size_t WS_CTL = 0, CTL_ZERO_BYTES = 1 * MiB;
constexpr size_t WS_WIN = 2 * MiB, WS_WGLU = 6 * MiB, WS_WOUT = 7 * MiB, WS_WPE = 9 * MiB, WS_WPG = 10 * MiB, WS_WUP = 12 * MiB, WS_WDN = 20 * MiB;
constexpr size_t WS_SE = 28 * MiB;
constexpr size_t WS_STF = 32 * MiB;
constexpr size_t WS_CNEG = 38 * MiB;
constexpr size_t WS_US = 39 * MiB;
constexpr size_t WS_XN0 = 40 * MiB;
constexpr size_t WS_H0 = 80 * MiB;
constexpr size_t WS_QB = 150 * MiB, WS_KB = 167 * MiB, WS_VB = 184 * MiB;
constexpr size_t WS_UX = 204 * MiB;
constexpr size_t WS_PB = 230 * MiB;
constexpr size_t WS_PE = 240 * MiB;
constexpr size_t WS_MIX = 276 * MiB;
constexpr size_t WS_ACT = 312 * MiB;
constexpr size_t WS_PRE = 330 * MiB;
constexpr size_t WS_H1 = 400 * MiB;
constexpr size_t WS_XN1 = 470 * MiB;
constexpr size_t WS_EP = 506 * MiB;
constexpr size_t WS_FFH = 576 * MiB;
constexpr size_t WS_PART = 712 * MiB;
constexpr size_t WS_END = 732 * MiB;
constexpr int CW_TMO = 0, CW_CODE = 1, CW_BAR = 4096;
constexpr int PART_REC = 68;

constexpr int RING_OFF = 0, RING_BYTES = 131072;
constexpr int LDSCTL_OFF = RING_BYTES, MISC_OFF = LDSCTL_OFF + 320;
constexpr int LDS_BYTES = 147456;
static_assert(MISC_OFF + 128 <= LDS_BYTES, "LDS map");

#define GAS __attribute__((address_space(1)))
#define LAS __attribute__((address_space(3)))
typedef unsigned short bf16;
typedef unsigned v4u __attribute__((ext_vector_type(4)));
typedef float f32x4 __attribute__((ext_vector_type(4)));
typedef GAS unsigned gu32;
typedef unsigned long long u64;
#define RLX_AGENT __ATOMIC_RELAXED, __HIP_MEMORY_SCOPE_AGENT
#define LDS_WAIT() asm volatile("s_waitcnt lgkmcnt(0)" ::: "memory")
#define VM_WAIT() asm volatile("s_waitcnt vmcnt(0)" ::: "memory")
__device__ __forceinline__ unsigned f2bf(float f) { unsigned u = __builtin_bit_cast(unsigned, f); return (u + 0x7fffu + ((u >> 16) & 1u)) >> 16; }
__device__ __forceinline__ unsigned pk2(float lo, float hi) { return f2bf(lo) | (f2bf(hi) << 16); }

#define XB_TMO      128
#define XB_XCNT(j)  (256  + 64 * (j))
#define XB_XSUB(j)  (1280 + 64 * (j))
#define XB_XGEN(j)  (2304 + 64 * (j))
#define XB_TOP      3328
#define XB_TOPGEN   3392
#define XCD_BAR_WORDS 3456
#define XB_SPIN_CAP (1u << 18)

__device__ __forceinline__ unsigned xb_ld(unsigned* p)              { return __hip_atomic_load(p, __ATOMIC_RELAXED, __HIP_MEMORY_SCOPE_AGENT); }
__device__ __forceinline__ unsigned xb_add(unsigned* p, unsigned v) { return __hip_atomic_fetch_add(p, v, __ATOMIC_RELAXED, __HIP_MEMORY_SCOPE_AGENT); }
__device__ __forceinline__ unsigned xb_xcc_id() { return (unsigned)__builtin_amdgcn_s_getreg((3 << 11) | 20) & 0xFu; }
#define XB_SPIN(cond, bar) do { unsigned _sp = 0; while (cond) { __builtin_amdgcn_s_sleep(1); \
    if ((++_sp & 255u) == 0u) { if (xb_ld(&(bar)[XB_TMO])) break; if (_sp > XB_SPIN_CAP) { atomicAdd(&(bar)[XB_TMO], 1u); break; } } } } while (0)

struct XcdBarrier {
    unsigned* bar; unsigned x;
    volatile LAS unsigned* st;
};

__device__ __forceinline__ XcdBarrier xcd_barrier_post(unsigned* bar, volatile LAS unsigned* st) {
    XcdBarrier b; b.bar = bar; b.x = xb_xcc_id(); b.st = st;
    if (threadIdx.x == 0) (void)xb_add(&bar[XB_XCNT(b.x)], 1u);
    return b;
}
__device__ __forceinline__ void xcd_barrier_complete(unsigned* bar, unsigned x, unsigned& nloc, unsigned& nx) {
    const unsigned G = gridDim.x * gridDim.y * gridDim.z;
    unsigned sum, cnt, mine, sp = 0u;
    for (;;) {
        sum = 0u; cnt = 0u; mine = 0u;
#pragma unroll
        for (unsigned j = 0; j < 16; ++j) { const unsigned c = xb_ld(&bar[XB_XCNT(j)]); sum += c; cnt += (c > 0u) ? 1u : 0u; mine = (j == x) ? c : mine; }
        if (sum == G) break;
        __builtin_amdgcn_s_sleep(1);
        if ((++sp & 255u) == 0u) { if (xb_ld(&bar[XB_TMO])) break; if (sp > XB_SPIN_CAP) { atomicAdd(&bar[XB_TMO], 1u); break; } }
    }
    nloc = mine > 0u ? mine : 1u; nx = cnt > 0u ? cnt : 1u;
}

__device__ __forceinline__ void xcd_barrier(const XcdBarrier& b) {
    asm volatile("s_waitcnt vmcnt(0)" ::: "memory");
    __syncthreads();
    if (threadIdx.x == 0) {
        unsigned* bar = b.bar;
        __builtin_amdgcn_s_waitcnt(0);
        unsigned nloc = b.st[0], nx = b.st[1];
        if (nloc == 0u) { xcd_barrier_complete(bar, b.x, nloc, nx); b.st[0] = nloc; b.st[1] = nx; }
        const unsigned old = xb_add(&bar[XB_XSUB(b.x)], 1u);
        const unsigned gen = old / nloc;
        if (old + 1u == (gen + 1u) * nloc) {
            __builtin_amdgcn_fence(__ATOMIC_RELEASE, "agent");
            asm volatile("s_waitcnt vmcnt(0)" ::: "memory");
            const unsigned og = xb_add(&bar[XB_TOP], 1u);
            const unsigned tg = og / nx;
            if (og + 1u == (tg + 1u) * nx) xb_add(&bar[XB_TOPGEN], 1u);
            else XB_SPIN(xb_ld(&bar[XB_TOPGEN]) == tg, bar);
            __builtin_amdgcn_fence(__ATOMIC_ACQUIRE, "agent");
            xb_add(&bar[XB_XGEN(b.x)], 1u);
            asm volatile("s_waitcnt vmcnt(0)" ::: "memory");
        } else {
            XB_SPIN(xb_ld(&bar[XB_XGEN(b.x)]) == gen, bar);
            __builtin_amdgcn_fence(__ATOMIC_ACQUIRE, "agent");
            asm volatile("s_waitcnt vmcnt(0)" ::: "memory");
        }
    }
    __syncthreads();
}


struct Frame {
    LAS unsigned char* lds;
    volatile LAS unsigned* MISC;
    gu32* ctl;
    int tid, lane, wave, vcu, G;
    const float *x_prompt, *x_sample, *cache_k, *cache_v, *cache_logf, *state_re, *state_im; const int* page_table;
    const float *p_prompt, *p_sample, *ln_in_g, *ln_in_b, *w_in, *b_f, *lam_re, *lam_im, *log_dt, *b_re, *b_im, *c_re, *c_im, *d_skip, *w_glu, *b_glu, *w_out, *ln1_g, *ln1_b,
                *w_up, *w_down, *w_pe, *w_pg, *b_pg, *ln2_g, *ln2_b;
    float* out;
    bf16 *WIN, *WGLU, *WOUT, *WPE, *WPG, *WUP, *WDN, *SE, *STF, *US, *XN0, *QB, *KB, *VB, *UX, *PB, *PE, *MIX, *ACT, *XN1, *FFH;
    float *CNEG, *H0, *PRE, *H1, *EP, *PART;
};

__device__ __forceinline__ float wave_sum(float v) {
#pragma unroll
    for (int o = 1; o < 64; o <<= 1) v += __shfl_xor(v, o);
    return v;
}
__device__ __forceinline__ void p0_transpose_item(const float* W, int ldw, int K, int ncols, bf16* WT, int row_off, LAS float* scr, int item, int lane) {
    const int nblk = ncols / 32, kb = item / nblk, nb = item % nblk, k0 = 64 * kb, n0 = 32 * nb;
#pragma unroll 8
    for (int i = 0; i < 32; ++i) { const int kk = 2 * i + (lane >> 5); scr[kk * 33 + (lane & 31)] = W[(size_t)(k0 + kk) * ldw + n0 + (lane & 31)]; }
    LDS_WAIT(); asm volatile("" ::: "memory");
    const int c = lane & 7;
#pragma unroll
    for (int j = 0; j < 4; ++j) { const int n = (lane >> 3) + 8 * j; const LAS float* s = scr + (8 * c) * 33 + n;
        v4u o; o.x = pk2(s[0 * 33], s[1 * 33]); o.y = pk2(s[2 * 33], s[3 * 33]); o.z = pk2(s[4 * 33], s[5 * 33]); o.w = pk2(s[6 * 33], s[7 * 33]);
        *(GAS v4u*)(WT + (size_t)(row_off + n0 + n) * K + k0 + 8 * c) = o; }
    LDS_WAIT(); asm volatile("" ::: "memory");
}

__device__ __forceinline__ float phase_red(float li, float dt, int n) {
    const double ph = (double)n * (double)li * (double)dt; const double k = rint(ph * 0.15915494309189535);
    return (float)(ph - k * 6.283185307179586);
}
__device__ __forceinline__ void cpow_lam(float lr, float li, float dt, int n, float& re, float& im) {
    const float mag = expf((float)n * lr * dt), r = phase_red(li, dt, n);
    re = mag * cosf(r); im = mag * sinf(r);
}
__device__ __forceinline__ void zoh_coef(float lr, float li, float dt, float& cr, float& ci) {
    const float r = phase_red(li, dt, 1), em1 = expm1f(lr * dt), c = cosf(r), s = sinf(r), sh = sinf(0.5f * r);
    const float nr = em1 * c - 2.0f * sh * sh, ni = (1.0f + em1) * s, den = lr * lr + li * li;
    cr = (nr * lr + ni * li) / den; ci = (ni * lr - nr * li) / den;
}
__device__ __forceinline__ float rdlane(float v, int l) { return __int_as_float(__builtin_amdgcn_readlane(__float_as_int(v), l)); }

__device__ __forceinline__ void p0_ssm_item(Frame& F, int it) {
    const int lane = F.lane;
    if (it < 1536) {
        const int kind = it >> 9, g = (it & 511) >> 4, q = it & 15, p = lane;
        const float lr = F.lam_re[g * 64 + p], li = F.lam_im[g * 64 + p], dt = expf(F.log_dt[g]);
        if (kind == 0) {
            const int tau = q; float ar, ai, cr, ci; cpow_lam(lr, li, dt, tau, ar, ai); zoh_coef(lr, li, dt, cr, ci);
            const float gr = ar * cr - ai * ci, gi = ar * ci + ai * cr;
            const int h = lane >> 2, hq = (lane & 3) * 4; float acc[4] = {0.f, 0.f, 0.f, 0.f};
            for (int pp = 0; pp < 64; ++pp) {
                const float grp = rdlane(gr, pp), gip = rdlane(gi, pp);
                const f32x4 br = *(const GAS f32x4*)(F.b_re + (size_t)(g * 64 + pp) * 16 + hq), bi = *(const GAS f32x4*)(F.b_im + (size_t)(g * 64 + pp) * 16 + hq);
                const float cre = F.c_re[(size_t)(g * 16 + h) * 64 + pp], cim = F.c_im[(size_t)(g * 16 + h) * 64 + pp];
#pragma unroll
                for (int e = 0; e < 4; ++e) { const float Gre = grp * br[e] - gip * bi[e], Gim = grp * bi[e] + gip * br[e]; acc[e] += cre * Gre - cim * Gim; }
            }
            const u64 w = (u64)pk2(acc[0], acc[1]) | ((u64)pk2(acc[2], acc[3]) << 32);
            bf16* T = F.STF + (size_t)g * 256 * 384;
            for (int j = tau; j < 16; ++j) *(GAS u64*)(T + (size_t)(j * 16 + h) * 384 + (j - tau) * 16 + hq) = w;
            if (tau >= 1) for (int j = 0; j + tau < 16; ++j) *(GAS u64*)(T + (size_t)(j * 16 + h) * 384 + (j + tau) * 16 + hq) = 0ull;
        } else if (kind == 1) {
            const int j = q; float ar, ai; cpow_lam(lr, li, dt, j + 1, ar, ai);
            bf16* T = F.STF + (size_t)g * 256 * 384;
            for (int h = 0; h < 16; ++h) { const float cre = F.c_re[(size_t)(g * 16 + h) * 64 + p], cim = F.c_im[(size_t)(g * 16 + h) * 64 + p];
                T[(size_t)(j * 16 + h) * 384 + 256 + p] = (bf16)f2bf(cre * ar - cim * ai); T[(size_t)(j * 16 + h) * 384 + 320 + p] = (bf16)f2bf(-(cre * ai + cim * ar)); }
        } else {
            const int i = q; float ar, ai, cr, ci; cpow_lam(lr, li, dt, 15 - i, ar, ai); zoh_coef(lr, li, dt, cr, ci);
            const float gr = ar * cr - ai * ci, gi = ar * ci + ai * cr;
            bf16* E = F.SE + (size_t)g * 256 * 256;
#pragma unroll
            for (int k = 0; k < 2; ++k) {
                const f32x4 r0 = *(const GAS f32x4*)(F.b_re + (size_t)(g * 64 + p) * 16 + 8 * k), r1 = *(const GAS f32x4*)(F.b_re + (size_t)(g * 64 + p) * 16 + 8 * k + 4);
                const f32x4 i0 = *(const GAS f32x4*)(F.b_im + (size_t)(g * 64 + p) * 16 + 8 * k), i1 = *(const GAS f32x4*)(F.b_im + (size_t)(g * 64 + p) * 16 + 8 * k + 4);
                v4u wr_, wi_;
                wr_.x = pk2(gr * r0[0] - gi * i0[0], gr * r0[1] - gi * i0[1]); wr_.y = pk2(gr * r0[2] - gi * i0[2], gr * r0[3] - gi * i0[3]);
                wr_.z = pk2(gr * r1[0] - gi * i1[0], gr * r1[1] - gi * i1[1]); wr_.w = pk2(gr * r1[2] - gi * i1[2], gr * r1[3] - gi * i1[3]);
                wi_.x = pk2(gr * i0[0] + gi * r0[0], gr * i0[1] + gi * r0[1]); wi_.y = pk2(gr * i0[2] + gi * r0[2], gr * i0[3] + gi * r0[3]);
                wi_.z = pk2(gr * i1[0] + gi * r1[0], gr * i1[1] + gi * r1[1]); wi_.w = pk2(gr * i1[2] + gi * r1[2], gr * i1[3] + gi * r1[3]);
                *(GAS v4u*)(E + (size_t)p * 256 + i * 16 + 8 * k) = wr_; *(GAS v4u*)(E + (size_t)(64 + p) * 256 + i * 16 + 8 * k) = wi_; }
        }
    } else {
        const int z = it - 1536, g = z >> 3, part = z & 7;
        GAS v4u* dst = (GAS v4u*)(F.SE + (size_t)g * 256 * 256 + 128 * 256) + part * 512 + lane;
#pragma unroll
        for (int k = 0; k < 8; ++k) dst[64 * k] = (v4u){0u, 0u, 0u, 0u};
    }
}

__device__ __forceinline__ void p0_row(Frame& F, int m, const f32x4 (&gv)[4], const f32x4 (&bv)[4], const LAS float* wflt) {
    const float* xrow = m < MP ? F.x_prompt + (size_t)m * DM_ : F.x_sample + (size_t)(m - MP) * DM_;
    const GAS f32x4* xr = (const GAS f32x4*)xrow + F.lane;
    f32x4 v[4]; float s = 0.f;
#pragma unroll
    for (int j = 0; j < 4; ++j) { v[j] = xr[64 * j]; s += (v[j].x + v[j].y) + (v[j].z + v[j].w); }
    const float mean = wave_sum(s) * (1.f / DM_); float s2 = 0.f;
#pragma unroll
    for (int j = 0; j < 4; ++j) { v[j] = v[j] - mean; s2 += (v[j].x * v[j].x + v[j].y * v[j].y) + (v[j].z * v[j].z + v[j].w * v[j].w); }
    const float rstd = 1.f / sqrtf(wave_sum(s2) * (1.f / DM_) + LN_EPS);
    GAS f32x4* h0 = (GAS f32x4*)(F.H0 + (size_t)m * DM_) + F.lane;
    GAS u64* o8 = (GAS u64*)(F.XN0 + (size_t)m * DM_) + F.lane;
#pragma unroll
    for (int j = 0; j < 4; ++j) { v[j] = v[j] * rstd * gv[j] + bv[j]; h0[64 * j] = v[j]; o8[64 * j] = (u64)pk2(v[j].x, v[j].y) | ((u64)pk2(v[j].z, v[j].w) << 32); }
    float fl[8];
#pragma unroll
    for (int hd = 0; hd < 8; ++hd) { float a = 0.f;
#pragma unroll
        for (int j = 0; j < 4; ++j) { const f32x4 w = *(const LAS f32x4*)(wflt + hd * 1024 + 4 * (F.lane + 64 * j)); a += (v[j].x * w.x + v[j].y * w.y) + (v[j].z * w.z + v[j].w * w.w); }
        fl[hd] = wave_sum(a); }
    float mine = fl[0];
#pragma unroll
    for (int hd = 1; hd < 8; ++hd) if ((F.lane & 7) == hd) mine = fl[hd];
    if (F.lane < 8) { const float x = mine + F.b_f[F.lane]; const float lf = fminf(x, 0.f) - log1pf(expf(-fabsf(x)));
        float* dst = m < MP ? F.out + OFF_LFP + (size_t)m * 8 : F.out + OFF_LFS + (size_t)(m - MP) * 8; dst[F.lane] = lf; }
    const float* prow = m < MP ? F.p_prompt + (size_t)m * PLE : F.p_sample + (size_t)(m - MP) * PLE;
    const f32x4 pv = ((const GAS f32x4*)prow)[F.lane];
    ((GAS u64*)(F.PB + (size_t)m * PLE))[F.lane] = (u64)pk2(pv.x, pv.y) | ((u64)pk2(pv.z, pv.w) << 32);
}

__device__ __forceinline__ void p0_prologue(Frame& F) {
    LAS float* scr = (LAS float*)(F.lds + RING_OFF + F.wave * 9216);
    LAS float* wflt = (LAS float*)(F.lds + RING_OFF + 73728);
    for (int idx = F.tid; idx < 8192; idx += NWAVES * 64) { const int hd = idx & 7, k = idx >> 3; wflt[hd * 1024 + k] = F.w_in[(size_t)k * INW + 1536 + hd]; }
    __syncthreads();
    const int gw = F.vcu * NWAVES + F.wave, NGW = F.G * NWAVES;
    constexpr int I_QKV = 16 * 48, I_U = 16 * 16, I_GLU = 8 * 16, I_OUT = 16 * 32, I_PE = 4 * 32, I_PG = 16 * 32, I_UP = 16 * 128, I_DN = 64 * 32;
    constexpr int NTR = I_QKV + I_U + I_GLU + I_OUT + I_PE + I_PG + I_UP + I_DN, NSSM = 1792;
    for (int it = gw; it < NTR + NSSM; it += NGW) {
        int r = it;
        if (r >= NTR) { p0_ssm_item(F, r - NTR); continue; }
        if (r < I_QKV) { p0_transpose_item(F.w_in, INW, DM_, 1536, F.WIN, 0, scr, r, F.lane); continue; } r -= I_QKV;
        if (r < I_U) { p0_transpose_item(F.w_in + 1544, INW, DM_, 512, F.WIN, 1536, scr, r, F.lane); continue; } r -= I_U;
        if (r < I_GLU) { p0_transpose_item(F.w_glu, 512, 512, 512, F.WGLU, 0, scr, r, F.lane); continue; } r -= I_GLU;
        if (r < I_OUT) { p0_transpose_item(F.w_out, DM_, DM_, DM_, F.WOUT, 0, scr, r, F.lane); continue; } r -= I_OUT;
        if (r < I_PE) { p0_transpose_item(F.w_pe, DM_, PLE, DM_, F.WPE, 0, scr, r, F.lane); continue; } r -= I_PE;
        if (r < I_PG) { p0_transpose_item(F.w_pg, DM_, DM_, DM_, F.WPG, 0, scr, r, F.lane); continue; } r -= I_PG;
        if (r < I_UP) { p0_transpose_item(F.w_up, FF_, DM_, FF_, F.WUP, 0, scr, r, F.lane); continue; } r -= I_UP;
        p0_transpose_item(F.w_down, DM_, FF_, DM_, F.WDN, 0, scr, r, F.lane);
    }
    f32x4 gv[4], bv[4];
#pragma unroll
    for (int j = 0; j < 4; ++j) { gv[j] = ((const GAS f32x4*)F.ln_in_g)[F.lane + 64 * j]; bv[j] = ((const GAS f32x4*)F.ln_in_b)[F.lane + 64 * j]; }
    for (int m = gw; m < MT; m += NGW) p0_row(F, m, gv, bv, wflt);
}

__device__ __forceinline__ void ln_rows(Frame& F, const float* src, const float* gam, const float* bet, float* df32, bf16* dbf) {
    const int gw = F.vcu * NWAVES + F.wave, NGW = F.G * NWAVES;
    f32x4 gv[4], bv[4];
#pragma unroll
    for (int j = 0; j < 4; ++j) { gv[j] = ((const GAS f32x4*)gam)[F.lane + 64 * j]; bv[j] = ((const GAS f32x4*)bet)[F.lane + 64 * j]; }
    for (int m = gw; m < MT; m += NGW) {
        const GAS f32x4* xr = (const GAS f32x4*)(src + (size_t)m * DM_) + F.lane;
        f32x4 v[4]; float s = 0.f;
#pragma unroll
        for (int j = 0; j < 4; ++j) { v[j] = xr[64 * j]; s += (v[j].x + v[j].y) + (v[j].z + v[j].w); }
        const float mean = wave_sum(s) * (1.f / DM_); float s2 = 0.f;
#pragma unroll
        for (int j = 0; j < 4; ++j) { v[j] = v[j] - mean; s2 += (v[j].x * v[j].x + v[j].y * v[j].y) + (v[j].z * v[j].z + v[j].w * v[j].w); }
        const float rstd = 1.f / sqrtf(wave_sum(s2) * (1.f / DM_) + LN_EPS);
        GAS f32x4* o4 = (GAS f32x4*)(df32 + (size_t)m * DM_) + F.lane;
#pragma unroll
        for (int j = 0; j < 4; ++j) { v[j] = v[j] * rstd * gv[j] + bv[j]; o4[64 * j] = v[j]; }
        if (dbf) { GAS u64* o8 = (GAS u64*)(dbf + (size_t)m * DM_) + F.lane;
#pragma unroll
            for (int j = 0; j < 4; ++j) o8[64 * j] = (u64)pk2(v[j].x, v[j].y) | ((u64)pk2(v[j].z, v[j].w) << 32); }
    }
}

__device__ __forceinline__ void cumsum_item(Frame& F, int bh) {
    const int b = bh >> 3, h = bh & 7, lane = F.lane;
    const float* src = F.out + OFF_LFP + ((size_t)b * SEQ_ + (size_t)lane * 64) * 8 + h;
    double s = 0.0;
#pragma unroll 16
    for (int i = 0; i < 64; ++i) s += (double)src[(size_t)i * 8];
    double inc = s;
#pragma unroll
    for (int off = 1; off < 64; off <<= 1) { const double t = __shfl_up(inc, off); if (lane >= off) inc += t; }
    double run = inc - s;
    float* dst = F.CNEG + (size_t)bh * SEQ_ + lane * 64;
#pragma unroll 16
    for (int i = 0; i < 64; ++i) { run += (double)src[(size_t)i * 8]; dst[i] = (float)(-run * 1.4426950408889634); }
}

template <int HALFN, int MASK> __device__ __forceinline__ void bfly_step(float (&v)[64], int lane) {
    const bool up = (lane & MASK) != 0;
#pragma unroll
    for (int k = 0; k < HALFN; ++k) { const float keep = up ? v[k + HALFN] : v[k]; const float send = up ? v[k] : v[k + HALFN]; v[k] = keep + __shfl_xor(send, MASK); }
}
__device__ __forceinline__ void ssm_sample_item(Frame& F, int it) {
    const int b = it >> 5, g = it & 31, p = F.lane;
    const float lr = F.lam_re[g * 64 + p], li = F.lam_im[g * 64 + p], dt = expf(F.log_dt[g]);
    float ar, ai, cr, ci; cpow_lam(lr, li, dt, 1, ar, ai); zoh_coef(lr, li, dt, cr, ci);
    float bbr[16], bbi[16];
#pragma unroll
    for (int k = 0; k < 4; ++k) { const f32x4 r = *(const GAS f32x4*)(F.b_re + (size_t)(g * 64 + p) * 16 + 4 * k), i = *(const GAS f32x4*)(F.b_im + (size_t)(g * 64 + p) * 16 + 4 * k);
#pragma unroll
        for (int e = 0; e < 4; ++e) { bbr[4 * k + e] = cr * r[e] - ci * i[e]; bbi[4 * k + e] = cr * i[e] + ci * r[e]; } }
    float xr = F.state_re[(size_t)(b * 32 + g) * 64 + p], xi = F.state_im[(size_t)(b * 32 + g) * 64 + p];
    const float uval = __uint_as_float((unsigned)F.US[(size_t)(b * 4 + (p >> 4)) * 512 + g * 16 + (p & 15)] << 16);
    float cre[16], cim[16];
#pragma unroll
    for (int h = 0; h < 16; ++h) { cre[h] = F.c_re[(size_t)(g * 16 + h) * 64 + p]; cim[h] = F.c_im[(size_t)(g * 16 + h) * 64 + p]; }
    float part[64];
#pragma unroll
    for (int t = 0; t < 4; ++t) { float bur = 0.f, bui = 0.f;
#pragma unroll
        for (int h = 0; h < 16; ++h) { const float uu = rdlane(uval, t * 16 + h); bur += bbr[h] * uu; bui += bbi[h] * uu; }
        const float nxr = ar * xr - ai * xi + bur, nxi = ar * xi + ai * xr + bui; xr = nxr; xi = nxi;
#pragma unroll
        for (int h = 0; h < 16; ++h) part[t * 16 + h] = cre[h] * xr - cim[h] * xi; }
    F.out[OFF_SRS + (size_t)(b * 32 + g) * 64 + p] = xr; F.out[OFF_SIS + (size_t)(b * 32 + g) * 64 + p] = xi;
    bfly_step<32, 32>(part, p); bfly_step<16, 16>(part, p); bfly_step<8, 8>(part, p); bfly_step<4, 4>(part, p); bfly_step<2, 2>(part, p); bfly_step<1, 1>(part, p);
    const float y = part[0] + F.d_skip[g * 16 + (p & 15)] * uval;
    F.ACT[(size_t)(MP + b * 4 + (p >> 4)) * 512 + g * 16 + (p & 15)] = (bf16)f2bf(pg8::gelu_tanh(y));
}

template <int CTRL> __device__ __forceinline__ float dppf(float x) { return __builtin_bit_cast(float, __builtin_amdgcn_mov_dpp(__builtin_bit_cast(int, x), CTRL, 0xf, 0xf, true)); }
__device__ __forceinline__ float rowsum16(float x) { x += dppf<0xB1>(x); x += dppf<0x4E>(x); x += dppf<0x141>(x); x += dppf<0x128>(x); return x; }
__device__ __forceinline__ float xrow_max(float x) {
    auto s = __builtin_amdgcn_permlane16_swap(__float_as_uint(x), __float_as_uint(x), false, false); x = fmaxf(__uint_as_float(s[0]), __uint_as_float(s[1]));
    auto t = __builtin_amdgcn_permlane32_swap(__float_as_uint(x), __float_as_uint(x), false, false); return fmaxf(__uint_as_float(t[0]), __uint_as_float(t[1]));
}
__device__ __forceinline__ float xrow_sum(float x) {
    auto s = __builtin_amdgcn_permlane16_swap(__float_as_uint(x), __float_as_uint(x), false, false); x = __uint_as_float(s[0]) + __uint_as_float(s[1]);
    auto t = __builtin_amdgcn_permlane32_swap(__float_as_uint(x), __float_as_uint(x), false, false); return __uint_as_float(t[0]) + __uint_as_float(t[1]);
}
constexpr int DEC_WB_OFF = 0;
__device__ __forceinline__ void decode_item(Frame& F, int item) {
    const int b = item >> 4, h = F.wave, lane = F.lane, jq = lane >> 4, ds = lane & 15;
    const int phys = F.page_table[item];
    const float* Kp = F.cache_k + (size_t)phys * 65536 + h * 64 + ds * 4;
    const float* Vp = F.cache_v + (size_t)phys * 65536 + h * 64 + ds * 4;
    const float* Fp = F.cache_logf + (size_t)phys * 1024 + h;
    float q[4][4];
#pragma unroll
    for (int qi = 0; qi < 4; ++qi) { const pg8::u32x2 w = *(const pg8::u32x2*)(F.QB + (size_t)(MP + b * 4 + qi) * AW + h * 64 + ds * 4);
        q[qi][0] = pg8::bf_lo(w.x); q[qi][1] = pg8::bf_hi(w.x); q[qi][2] = pg8::bf_lo(w.y); q[qi][3] = pg8::bf_hi(w.y); }
    LAS float* wb = (LAS float*)(F.lds + DEC_WB_OFF) + h * 128;
    float pagesum;
    { const float f0 = Fp[(2 * lane) * 8], f1 = Fp[(2 * lane + 1) * 8]; const float a = f0 + f1; float suf = a;
#pragma unroll
      for (int off = 1; off < 64; off <<= 1) { const float t = __shfl_down(suf, off); if (lane + off < 64) suf += t; }
      const float W1 = suf - a, W0 = W1 + f1; wb[2 * lane] = W0 * LOG2E; wb[2 * lane + 1] = W1 * LOG2E;
      pagesum = rdlane(suf, 0) * LOG2E; }
    LDS_WAIT();
    float m[4], l[4], o[4][4];
#pragma unroll
    for (int qi = 0; qi < 4; ++qi) { m[qi] = -INFINITY; l[qi] = 0.f; o[qi][0] = o[qi][1] = o[qi][2] = o[qi][3] = 0.f; }
    f32x4 kA[4], vA[4], kB[4], vB[4];
#define DEC_LOAD(kk, vv, bi) do { _Pragma("unroll") for (int u_ = 0; u_ < 4; ++u_) { const size_t ro_ = (size_t)(4 * (4 * (bi) + u_) + jq) * 512; \
        kk[u_] = __builtin_nontemporal_load((const f32x4*)(Kp + ro_)); vv[u_] = __builtin_nontemporal_load((const f32x4*)(Vp + ro_)); } } while (0)
#define DEC_COMP(kk, vv, bi) do { _Pragma("unroll") for (int u_ = 0; u_ < 4; ++u_) { const float w_ = wb[4 * (4 * (bi) + u_) + jq]; \
        _Pragma("unroll") for (int qi = 0; qi < 4; ++qi) { float s_ = (kk[u_].x * q[qi][0] + kk[u_].y * q[qi][1]) + (kk[u_].z * q[qi][2] + kk[u_].w * q[qi][3]); s_ = rowsum16(s_) + w_; \
            const float mn_ = fmaxf(m[qi], s_), sc_ = __builtin_amdgcn_exp2f(m[qi] - mn_), pp_ = __builtin_amdgcn_exp2f(s_ - mn_); m[qi] = mn_; l[qi] = l[qi] * sc_ + pp_; \
            o[qi][0] = o[qi][0] * sc_ + pp_ * vv[u_].x; o[qi][1] = o[qi][1] * sc_ + pp_ * vv[u_].y; o[qi][2] = o[qi][2] * sc_ + pp_ * vv[u_].z; o[qi][3] = o[qi][3] * sc_ + pp_ * vv[u_].w; } } } while (0)
    DEC_LOAD(kA, vA, 0);
#pragma unroll 1
    for (int bi = 0; bi < 8; bi += 2) {
        DEC_LOAD(kB, vB, bi + 1);
        DEC_COMP(kA, vA, bi);
        if (bi + 2 < 8) DEC_LOAD(kA, vA, bi + 2);
        DEC_COMP(kB, vB, bi + 1);
    }
#undef DEC_LOAD
#undef DEC_COMP
    float* rec = F.PART + ((size_t)(item * 8 + h) * 4) * PART_REC;
#pragma unroll
    for (int qi = 0; qi < 4; ++qi) { const float mall = xrow_max(m[qi]), sc = __builtin_amdgcn_exp2f(m[qi] - mall); const float lall = xrow_sum(l[qi] * sc);
        f32x4 oa; oa.x = xrow_sum(o[qi][0] * sc); oa.y = xrow_sum(o[qi][1] * sc); oa.z = xrow_sum(o[qi][2] * sc); oa.w = xrow_sum(o[qi][3] * sc);
        if (jq == 0) { *(f32x4*)(rec + qi * PART_REC + 4 + ds * 4) = oa; if (ds == 0) *(f32x4*)(rec + qi * PART_REC) = (f32x4){mall, lall, pagesum, 0.f}; } }
}
__device__ __forceinline__ void decode_combine_item(Frame& F, int it) {
    const int b = it >> 3, h = it & 7, lane = F.lane, qi = lane >> 4, ds = lane & 15;
    float lfn[4];
#pragma unroll
    for (int t = 0; t < 4; ++t) lfn[t] = F.out[OFF_LFS + (size_t)(b * 4 + t) * 8 + h] * LOG2E;
    float N = 0.f;
#pragma unroll
    for (int t = 0; t < 4; ++t) if (t <= qi) N += lfn[t];
    const pg8::u32x2 qw = *(const pg8::u32x2*)(F.QB + (size_t)(MP + b * 4 + qi) * AW + h * 64 + ds * 4);
    const float q0 = pg8::bf_lo(qw.x), q1 = pg8::bf_hi(qw.x), q2 = pg8::bf_lo(qw.y), q3 = pg8::bf_hi(qw.y);
    float st[4]; f32x4 vn[4];
#pragma unroll
    for (int t = 0; t < 4; ++t) { const f32x4 k4 = *(const f32x4*)(F.out + OFF_KS + (size_t)(b * 4 + t) * AW + h * 64 + ds * 4); vn[t] = *(const f32x4*)(F.out + OFF_VS + (size_t)(b * 4 + t) * AW + h * 64 + ds * 4);
        float s = rowsum16((k4.x * q0 + k4.y * q1) + (k4.z * q2 + k4.w * q3)); float bias = 0.f;
#pragma unroll
        for (int t2 = 1; t2 < 4; ++t2) if (t2 > t && t2 <= qi) bias += lfn[t2];
        st[t] = (t <= qi) ? s + bias : -INFINITY; }
    float M = fmaxf(fmaxf(st[0], st[1]), fmaxf(st[2], st[3]));
    const float* rec0 = F.PART + ((size_t)((b * 16) * 8 + h) * 4 + qi) * PART_REC;
    float R = 0.f;
    for (int p = 15; p >= 0; --p) { const f32x4 hd = *(const f32x4*)(rec0 + (size_t)p * 32 * PART_REC); M = fmaxf(M, hd.x + R + N); R += hd.z; }
    float L = 0.f; f32x4 O = (f32x4){0.f, 0.f, 0.f, 0.f};
#pragma unroll
    for (int t = 0; t < 4; ++t) { const float w = __builtin_amdgcn_exp2f(st[t] - M); L += w; O = O + vn[t] * w; }
    R = 0.f;
    for (int p = 15; p >= 0; --p) { const float* rp = rec0 + (size_t)p * 32 * PART_REC; const f32x4 hd = *(const f32x4*)rp; const f32x4 op = *(const f32x4*)(rp + 4 + ds * 4);
        const float w = __builtin_amdgcn_exp2f(hd.x + R + N - M); L += hd.y * w; O = O + op * w; R += hd.z; }
    const float inv = 1.0f / L;
    *(GAS u64*)(F.MIX + (size_t)(MP + b * 4 + qi) * DM_ + h * 64 + ds * 4) = (u64)pk2(O.x * inv, O.y * inv) | ((u64)pk2(O.z * inv, O.w * inv) << 32);
}

namespace pg8 {
__device__ __forceinline__ void EpiSsmA::fused(f32x4 (&acc)[2][2][4][2], const Unit& u, int wr, int wc, int fr, int fq, PG8_LAS unsigned char* lds, int wid, int lane) const {
    const int g = u.pm >> 2, b = u.pm & 3;
    PG8_LAS float* T = (PG8_LAS float*)lds;
    float a16r = 0.f, a16i = 0.f, xr = 0.f, xi = 0.f;
    if (wid == 0) { const float lr = lam_re[g * 64 + lane], li = lam_im[g * 64 + lane], dt = expf(log_dt[g]); cpow_lam(lr, li, dt, 16, a16r, a16i); }
#pragma unroll
    for (int ai = 0; ai < 2; ++ai) {
#pragma unroll
        for (int m = 0; m < 4; ++m)
#pragma unroll
            for (int n = 0; n < 2; ++n) *(PG8_LAS f32x4*)(T + (wr * 64 + m * 16 + fr) * 132 + wc * 32 + 16 * n + 4 * fq) = acc[ai][0][m][n];
        asm volatile("s_waitcnt lgkmcnt(0)" ::: "memory"); __builtin_amdgcn_s_barrier(); asm volatile("" ::: "memory");
        if (wid == 0) {
            bf16_t* xrow = UX + ((size_t)(g * 1024 + b * 256 + ai * 128)) * 384 + 256 + lane;
#pragma unroll 4
            for (int r = 0; r < 128; ++r) { const float sr = T[r * 132 + lane], si = T[r * 132 + 64 + lane];
                xrow[(size_t)r * 384] = (bf16_t)f2bf(xr); xrow[(size_t)r * 384 + 64] = (bf16_t)f2bf(xi);
                const float nxr = a16r * xr - a16i * xi + sr, nxi = a16r * xi + a16i * xr + si; xr = nxr; xi = nxi; }
        }
        asm volatile("s_waitcnt lgkmcnt(0)" ::: "memory"); __builtin_amdgcn_s_barrier(); asm volatile("" ::: "memory");
    }
    if (wid == 0) { out[OFF_SRP + (size_t)(b * 32 + g) * 64 + lane] = xr; out[OFF_SIP + (size_t)(b * 32 + g) * 64 + lane] = xi; }
}
}

struct Args { const void* in[34]; float* out; unsigned char* ws; int ph_lo, ph_hi, li, pad; };
__global__ void __launch_bounds__(NWAVES * 64, 2) fwd(Args args) {
    extern __shared__ __attribute__((aligned(16))) unsigned char lds[];
    Frame F;
    F.lds = (LAS unsigned char*)lds;
    F.MISC = (volatile LAS unsigned*)(F.lds + MISC_OFF);
    F.tid = threadIdx.x; F.lane = F.tid & 63; F.wave = __builtin_amdgcn_readfirstlane(F.tid >> 6);
    F.G = gridDim.x; { const int bx = blockIdx.x; F.vcu = (F.G % 8 == 0) ? (bx % 8) * (F.G / 8) + bx / 8 : bx; }
    unsigned char* ws = args.ws;
    F.ctl = (gu32*)(ws + WS_CTL);
    F.x_prompt = (const float*)args.in[0]; F.x_sample = (const float*)args.in[1]; F.cache_k = (const float*)args.in[2]; F.cache_v = (const float*)args.in[3]; F.cache_logf = (const float*)args.in[4];
    F.state_re = (const float*)args.in[5]; F.state_im = (const float*)args.in[6]; F.page_table = (const int*)args.in[7]; F.p_prompt = (const float*)args.in[8]; F.p_sample = (const float*)args.in[9];
    F.ln_in_g = (const float*)args.in[10]; F.ln_in_b = (const float*)args.in[11]; F.w_in = (const float*)args.in[12]; F.b_f = (const float*)args.in[13]; F.lam_re = (const float*)args.in[14];
    F.lam_im = (const float*)args.in[15]; F.log_dt = (const float*)args.in[16]; F.b_re = (const float*)args.in[17]; F.b_im = (const float*)args.in[18]; F.c_re = (const float*)args.in[19];
    F.c_im = (const float*)args.in[20]; F.d_skip = (const float*)args.in[21]; F.w_glu = (const float*)args.in[22]; F.b_glu = (const float*)args.in[23]; F.w_out = (const float*)args.in[24];
    F.ln1_g = (const float*)args.in[25]; F.ln1_b = (const float*)args.in[26]; F.w_up = (const float*)args.in[27]; F.w_down = (const float*)args.in[28]; F.w_pe = (const float*)args.in[29];
    F.w_pg = (const float*)args.in[30]; F.b_pg = (const float*)args.in[31]; F.ln2_g = (const float*)args.in[32]; F.ln2_b = (const float*)args.in[33];
    F.out = args.out;
    F.WIN = (bf16*)(ws + WS_WIN); F.WGLU = (bf16*)(ws + WS_WGLU); F.WOUT = (bf16*)(ws + WS_WOUT); F.WPE = (bf16*)(ws + WS_WPE); F.WPG = (bf16*)(ws + WS_WPG); F.WUP = (bf16*)(ws + WS_WUP); F.WDN = (bf16*)(ws + WS_WDN);
    F.SE = (bf16*)(ws + WS_SE); F.STF = (bf16*)(ws + WS_STF); F.US = (bf16*)(ws + WS_US); F.XN0 = (bf16*)(ws + WS_XN0); F.QB = (bf16*)(ws + WS_QB); F.KB = (bf16*)(ws + WS_KB); F.VB = (bf16*)(ws + WS_VB);
    F.UX = (bf16*)(ws + WS_UX); F.PB = (bf16*)(ws + WS_PB); F.PE = (bf16*)(ws + WS_PE); F.MIX = (bf16*)(ws + WS_MIX); F.ACT = (bf16*)(ws + WS_ACT); F.XN1 = (bf16*)(ws + WS_XN1); F.FFH = (bf16*)(ws + WS_FFH);
    F.CNEG = (float*)(ws + WS_CNEG); F.H0 = (float*)(ws + WS_H0); F.PRE = (float*)(ws + WS_PRE); F.H1 = (float*)(ws + WS_H1); F.EP = (float*)(ws + WS_EP); F.PART = (float*)(ws + WS_PART);
    for (int u = F.tid; u < (LDS_BYTES - LDSCTL_OFF) / 4; u += NWAVES * 64) ((LAS unsigned*)(F.lds + LDSCTL_OFF))[u] = 0u;
    __syncthreads();
    XcdBarrier bar; bar.bar = (unsigned*)(F.ctl + CW_BAR); bar.x = 0; bar.st = nullptr;
    if (N_LAUNCHES != PER_PHASE) bar = xcd_barrier_post((unsigned*)(F.ctl + CW_BAR), F.MISC + 8);
#define GRID_BAR(seam) do { if (N_LAUNCHES == PER_PHASE) { if (F.tid == 0) __hip_atomic_store(F.ctl + CW_TMO, 0xBADBA0u | (unsigned)(seam), RLX_AGENT); } else { xcd_barrier(bar); } } while (0)
    const int lo = args.ph_lo, hi = args.ph_hi;
#ifndef PH_MASK
#define PH_MASK 0x3ff
#endif
#define IN(k) ((((PH_MASK) >> (k)) & 1) && lo <= (k) && (k) < hi)
#define BOTH(k) (IN(k) && IN((k) + 1))
    const int gw = F.vcu * NWAVES + F.wave, NGW = F.G * NWAVES;
    const int cblk = (int)blockIdx.x;

    if (IN(0)) { p0_prologue(F); if (BOTH(0)) GRID_BAR(0); }

    if (IN(1)) {
        { pg8::Gemm g{F.XN0, F.WIN, MT, 2048, DM_, DM_, DM_, 0, 0}; pg8::StaticOrder S; S.init(MT, 2048, F.G, cblk);
          pg8::EpiInProj E{F.QB, F.KB, F.VB, F.UX, F.US, F.out};
          pg8::gemm_phase<pg8::EpiInProj, pg8::StaticOrder, true>(F.lds + RING_OFF, g, S, E); }
        { pg8::Gemm g{F.PB, F.WPE, MT, DM_, PLE, PLE, PLE, 0, 0}; pg8::StaticOrder S; S.init(MT, DM_, F.G, cblk);
          pg8::EpiBf16<0> E{F.PE, DM_};
          pg8::gemm_phase<pg8::EpiBf16<0>, pg8::StaticOrder, true>(F.lds + RING_OFF, g, S, E); }
        if (BOTH(1)) GRID_BAR(1);
    }

    if (IN(2)) {
        { pg8::Gemm g{F.UX, F.SE, 32768, 256, 256, 384, 256, 4, (size_t)256 * 256 * 2}; pg8::StaticOrder S; S.init(32768, 256, F.G, cblk);
          pg8::EpiSsmA E{F.UX, F.out, F.lam_re, F.lam_im, F.log_dt};
          pg8::gemm_phase<pg8::EpiSsmA, pg8::StaticOrder, false>(F.lds + RING_OFF, g, S, E); }
        { const bool split = F.G > 128; const int fb = split ? cblk - 128 : cblk, nfb = split ? F.G - 128 : F.G;
          if (fb >= 0) { const int w0 = fb * NWAVES + F.wave, nw = nfb * NWAVES;
              for (int it = w0; it < 32 + DB_ * NG; it += nw) { if (it < 32) cumsum_item(F, it); else ssm_sample_item(F, it - 32); } } }
        if (BOTH(2)) GRID_BAR(2);
    }

    if (IN(3)) {
        static_assert(attn_body::ATTN_LDS_BYTES <= RING_BYTES, "attention LDS");
#ifndef NO_ATT
        { const attn_body::AttnTensors AT{(const attn_body::bf16*)F.QB, (const attn_body::bf16*)F.KB, (const attn_body::bf16*)F.VB, (attn_body::bf16*)F.MIX, F.CNEG};
          const attn_body::StaticOrder S((int)F.G, cblk);
          attn_body::attn_phase<attn_body::StaticOrder>((char*)lds + RING_OFF, AT, S); }
#endif
#ifndef NO_SSMB
        { pg8::Gemm g{F.UX, F.STF, 32768, 256, 384, 384, 384, 4, (size_t)256 * 384 * 2}; pg8::StaticOrder S; S.init(32768, 256, F.G, cblk);
          pg8::EpiSsmB E{F.UX, F.ACT, F.d_skip};
          pg8::gemm_phase<pg8::EpiSsmB, pg8::StaticOrder, true>(F.lds + RING_OFF, g, S, E); }
#endif
        __syncthreads();
#ifndef NO_DEC
        for (int item = cblk; item < DB_ * NPG; item += F.G) decode_item(F, item);
#endif
        if (BOTH(3)) GRID_BAR(3);
    }

    if (IN(4)) {
        for (int it = gw; it < DB_ * NH; it += NGW) decode_combine_item(F, it);
        { pg8::Gemm g{F.ACT, F.WGLU, MT, 512, 512, 512, 512, 0, 0}; pg8::StaticOrder S; S.init(MT, 512, F.G, cblk);
          pg8::EpiGlu E{F.ACT, F.MIX, F.b_glu};
          pg8::gemm_phase<pg8::EpiGlu, pg8::StaticOrder, true>(F.lds + RING_OFF, g, S, E); }
        if (BOTH(4)) GRID_BAR(4);
    }

    if (IN(5)) {
        { pg8::Gemm g{F.MIX, F.WOUT, MT, DM_, DM_, DM_, DM_, 0, 0}; pg8::StaticOrder S; S.init(MT, DM_, F.G, cblk);
          pg8::EpiF32<0> E{F.H0, F.PRE, nullptr, nullptr};
          pg8::gemm_phase<pg8::EpiF32<0>, pg8::StaticOrder, true>(F.lds + RING_OFF, g, S, E); }
        if (BOTH(5)) GRID_BAR(5);
    }

    if (IN(6)) { ln_rows(F, F.PRE, F.ln1_g, F.ln1_b, F.H1, F.XN1); if (BOTH(6)) GRID_BAR(6); }

    if (IN(7)) {
        { pg8::Gemm g{F.XN1, F.WPG, MT, DM_, DM_, DM_, DM_, 0, 0}; pg8::StaticOrder S; S.init(MT, DM_, F.G, cblk);
          pg8::EpiF32<1> E{F.H1, F.EP, F.b_pg, F.PE};
          pg8::gemm_phase<pg8::EpiF32<1>, pg8::StaticOrder, true>(F.lds + RING_OFF, g, S, E); }
        { pg8::Gemm g{F.XN1, F.WUP, MT, FF_, DM_, DM_, DM_, 0, 0}; pg8::StaticOrder S; S.init(MT, FF_, F.G, cblk);
          pg8::EpiBf16<2> E{F.FFH, FF_};
          pg8::gemm_phase<pg8::EpiBf16<2>, pg8::StaticOrder, true>(F.lds + RING_OFF, g, S, E); }
        if (BOTH(7)) GRID_BAR(7);
    }

    if (IN(8)) {
        { pg8::Gemm g{F.FFH, F.WDN, MT, DM_, FF_, FF_, FF_, 0, 0}; pg8::StaticOrder S; S.init(MT, DM_, F.G, cblk);
          pg8::EpiF32<2> E{F.EP, F.PRE, nullptr, nullptr};
          pg8::gemm_phase<pg8::EpiF32<2>, pg8::StaticOrder, true>(F.lds + RING_OFF, g, S, E); }
        if (BOTH(8)) GRID_BAR(8);
    }

    if (IN(9)) { ln_rows(F, F.PRE, F.ln2_g, F.ln2_b, F.out, nullptr); }
#undef IN
#undef BOTH
}

extern "C" void kernel_launch(void* const* d_in, const int* in_sizes, int n_in, void* d_out, int out_size, void* d_ws, size_t ws_size, hipStream_t stream) {
    static int grid = 0;
    if (grid == 0) {
        if (n_in != 34 || (size_t)out_size != OUT_TOTAL || ws_size < WS_END) { fprintf(stderr, "kernel_launch: unexpected shapes: n_in %d out %d ws %zu; nothing launched\n", n_in, out_size, ws_size); grid = -1; return; }
        int dev = 0, cus = 0, per_cu = 0;
        if (hipGetDevice(&dev) != hipSuccess || hipDeviceGetAttribute(&cus, hipDeviceAttributeMultiprocessorCount, dev) != hipSuccess) { grid = -1; return; }
        if (hipFuncSetAttribute((const void*)fwd, hipFuncAttributeMaxDynamicSharedMemorySize, LDS_BYTES) != hipSuccess) { fprintf(stderr, "kernel_launch: hipFuncSetAttribute failed\n"); grid = -1; return; }
        if (hipOccupancyMaxActiveBlocksPerMultiprocessor(&per_cu, (const void*)fwd, NWAVES * 64, LDS_BYTES) != hipSuccess || per_cu < 1) fprintf(stderr, "kernel_launch: note: occupancy query says %d\n", per_cu);
        (void)hipGetLastError();
        if (cus < 256) { fprintf(stderr, "kernel_launch: needs 256 CUs, device has %d\n", cus); grid = -1; return; }
        grid = 256;
    }
    if (grid < 0) return;
    if (hipMemsetAsync((char*)d_ws + WS_CTL, 0, CTL_ZERO_BYTES, stream) != hipSuccess) return;
    Args a{};
    for (int i = 0; i < 34; ++i) a.in[i] = d_in[i];
    a.out = (float*)d_out; a.ws = (unsigned char*)d_ws;
    for (int li = 0; li < N_LAUNCHES; ++li) {
        a.ph_lo = (N_LAUNCHES == PER_PHASE) ? li : 0; a.ph_hi = (N_LAUNCHES == PER_PHASE) ? li + 1 : PER_PHASE; a.li = li; a.pad = 0;
        hipLaunchKernelGGL(fwd, dim3(grid), dim3(NWAVES * 64), LDS_BYTES, stream, a);
        const hipError_t le = hipPeekAtLastError();
        if (le != hipSuccess) { fprintf(stderr, "kernel_launch: launch %d failed: %s\n", li, hipGetErrorName(le)); break; }
    }
}
```
